# Optimizing an MI355X kernel written in HIP

```python
import math
import jax
import jax.numpy as jnp
from jax import lax
import numpy as np


D_MODEL = 1024
BATCH = 4
SEQ = 4096
DEPTH = 4

GRID_W = 64
CTX_LEN = 256
N_MOD = 9
EPS = 1e-6
D_FF = 2816
MIX_W = D_MODEL
ATTN_W = MIX_W // 2
POOL_W = MIX_W // 4
S5_W = MIX_W // 4
HEAD_DIM = 64
N_Q_HEADS = ATTN_W // HEAD_DIM
N_KV_HEADS = N_Q_HEADS // 4
Q_PER_KV = N_Q_HEADS // N_KV_HEADS
KV_W = N_KV_HEADS * HEAD_DIM
Q_BLOCK = 128
ROPE_THETA = 10000.0
AXIS_DIM = HEAD_DIM // 2
AXIS_FREQS = AXIS_DIM // 2
POOL_WINDOWS = (2, 4, 8, 16)
POOL_CH = POOL_W // len(POOL_WINDOWS)
S5_CH = 16
S5_GROUPS = S5_W // S5_CH
S5_STATE = 64
S5_DT_MIN = 0.001
S5_DT_MAX = 0.1
IN_W = ATTN_W + 2 * KV_W + POOL_W + S5_W
SPLITS = (ATTN_W, ATTN_W + KV_W, ATTN_W + 2 * KV_W, ATTN_W + 2 * KV_W + POOL_W)

kernel_name = 'hybrid_flow_backbone_pool_s5_gqa'


def rmsnorm(x, g):
    xf = x.astype(jnp.float32)
    y = xf * lax.rsqrt(jnp.mean(xf * xf, axis=-1, keepdims=True) + EPS)
    return (y * g.astype(jnp.float32)).astype(x.dtype)


def adaln(cond, w, b):
    m = jax.nn.silu(cond) @ w + b
    return jnp.split(m[..., None, :], N_MOD, axis=-1)


def modulate(s, g, shift, scale):
    return rmsnorm(s, g) * (1 + scale) + shift


def swiglu(h, w_gate, w_up, w_down):
    return (jax.nn.silu(h @ w_gate) * (h @ w_up)) @ w_down


def axial_rope_tables(rows):
    row = jnp.broadcast_to(jnp.arange(rows, dtype=jnp.float32)[:, None], (rows, GRID_W)).reshape(-1)
    col = jnp.broadcast_to(jnp.arange(GRID_W, dtype=jnp.float32)[None, :], (rows, GRID_W)).reshape(-1)
    inv = ROPE_THETA ** (-2.0 * jnp.arange(AXIS_FREQS, dtype=jnp.float32) / AXIS_DIM)
    ang = jnp.concatenate([row[:, None] * inv, col[:, None] * inv], axis=-1)
    return jnp.cos(ang), jnp.sin(ang)


def apply_axial_rope(x, cos, sin):
    shape = x.shape
    xr = x.reshape(*shape[:-1], 2, 2, AXIS_FREQS)
    x1, x2 = xr[..., 0, :], xr[..., 1, :]
    bshape = (cos.shape[0],) + (1,) * (x.ndim - 3) + (2, AXIS_FREQS)
    cb = cos.reshape(bshape).astype(x.dtype)
    sb = sin.reshape(bshape).astype(x.dtype)
    out = jnp.stack([x1 * cb - x2 * sb, x2 * cb + x1 * sb], axis=-2)
    return out.reshape(shape)


def gqa_attend(q, k, v):
    s = jnp.einsum('bqgrd,bkgd->bgrqk', q, k).astype(jnp.float32) * (HEAD_DIM ** -0.5)
    p = jax.nn.softmax(s, axis=-1).astype(v.dtype)
    return jnp.einsum('bgrqk,bkgd->bqgrd', p, v)


def attention_branch(pc, pl, q_norm, k_norm, cos, sin, need_ctx_out):
    (qc, kc, vc), (ql, kl, vl) = pc, pl
    B, L, _ = ql.shape
    Lc = kc.shape[1]
    kc = rmsnorm(kc.reshape(B, Lc, N_KV_HEADS, HEAD_DIM), k_norm)
    vc = vc.reshape(B, Lc, N_KV_HEADS, HEAD_DIM)
    ql = apply_axial_rope(rmsnorm(ql.reshape(B, L, N_KV_HEADS, Q_PER_KV, HEAD_DIM), q_norm), cos, sin)
    kl = apply_axial_rope(rmsnorm(kl.reshape(B, L, N_KV_HEADS, HEAD_DIM), k_norm), cos, sin)
    vl = vl.reshape(B, L, N_KV_HEADS, HEAD_DIM)
    k_all = jnp.concatenate([kc, kl], axis=1)
    v_all = jnp.concatenate([vc, vl], axis=1)
    q_blocks = jnp.moveaxis(ql.reshape(B, L // Q_BLOCK, Q_BLOCK, N_KV_HEADS, Q_PER_KV, HEAD_DIM), 1, 0)
    o_blocks = lax.map(lambda qb: gqa_attend(qb, k_all, v_all), q_blocks)
    out_l = jnp.moveaxis(o_blocks, 0, 1).reshape(B, L, ATTN_W)
    out_c = None
    if need_ctx_out:
        qc = rmsnorm(qc.reshape(B, Lc, N_KV_HEADS, Q_PER_KV, HEAD_DIM), q_norm)
        out_c = gqa_attend(qc, kc, vc).reshape(B, Lc, ATTN_W)
    return out_c, out_l


def centred_window_mean(u, w):
    L = u.shape[1]
    uf = u.astype(jnp.float32)
    cs = jnp.concatenate([jnp.zeros_like(uf[:, :1]), jnp.cumsum(uf, axis=1)], axis=1)
    t = jnp.arange(L)
    lo = jnp.clip(t - w // 2, 0, L)
    hi = jnp.clip(t + (w - w // 2), 0, L)
    cnt = (hi - lo).astype(jnp.float32)[None, :, None]
    return ((cs[:, hi] - cs[:, lo]) / cnt).astype(u.dtype)


def pool_branch(u, pool_w, pool_scale):
    B, L, _ = u.shape
    g = u.reshape(B, L, len(POOL_WINDOWS), POOL_CH)
    pooled = jnp.stack([centred_window_mean(g[:, :, i], w) for i, w in enumerate(POOL_WINDOWS)], axis=2) - g
    y = jnp.einsum('blgc,gcd->blgd', pooled, pool_w).reshape(B, L, POOL_W)
    return y * pool_scale


def zoh_discretise(lam_re, lam_im, log_dt, b_re, b_im):
    f32 = jnp.float32
    dt = jnp.exp(log_dt.astype(f32))[:, None]
    lr, li = lam_re.astype(f32), lam_im.astype(f32)
    mag = jnp.exp(lr * dt)
    ab_re = mag * jnp.cos(li * dt)
    ab_im = mag * jnp.sin(li * dt)
    den = lr * lr + li * li
    f_re = ((ab_re - 1) * lr + ab_im * li) / den
    f_im = (ab_im * lr - (ab_re - 1) * li) / den
    br, bi = b_re.astype(f32), b_im.astype(f32)
    bb_re = f_re[..., None] * br - f_im[..., None] * bi
    bb_im = f_re[..., None] * bi + f_im[..., None] * br
    dtype = b_re.dtype
    return ab_re.astype(dtype), ab_im.astype(dtype), bb_re.astype(dtype), bb_im.astype(dtype)


def ssm_combine(e1, e2):
    a1r, a1i, b1r, b1i = e1
    a2r, a2i, b2r, b2i = e2
    return (a2r * a1r - a2i * a1i,
            a2r * a1i + a2i * a1r,
            a2r * b1r - a2i * b1i + b2r,
            a2r * b1i + a2i * b1r + b2i)


def diag_scan(ab_re, ab_im, bb_re, bb_im, u, s0_re, s0_im, reverse):
    bu_re = jnp.einsum('gph,blgh->blgp', bb_re, u)
    bu_im = jnp.einsum('gph,blgh->blgp', bb_im, u)
    first = -1 if reverse else 0
    last = 0 if reverse else -1
    bu_re = bu_re.at[:, first].add(ab_re * s0_re - ab_im * s0_im)
    bu_im = bu_im.at[:, first].add(ab_re * s0_im + ab_im * s0_re)
    a_re = jnp.broadcast_to(ab_re, bu_re.shape)
    a_im = jnp.broadcast_to(ab_im, bu_im.shape)
    _, _, s_re, s_im = lax.associative_scan(ssm_combine, (a_re, a_im, bu_re, bu_im), axis=1, reverse=reverse)
    return s_re, s_im, s_re[:, last], s_im[:, last]


def ssm_readout(c_re, c_im, s_re, s_im):
    return jnp.einsum('ghp,blgp->blgh', c_re, s_re) - jnp.einsum('ghp,blgp->blgh', c_im, s_im)


def s5_glu(y, glu_w, glu_b):
    g = jax.nn.gelu(y)
    return g * jax.nn.sigmoid(jnp.einsum('blgh,ghk->blgk', g, glu_w) + glu_b)


def s5_branch(uc, ul, lam_re, lam_im, log_dt, b_re, b_im, c_re, c_im, d_skip, glu_w, glu_b, need_ctx_out):
    B = ul.shape[0]
    uc = uc.reshape(B, uc.shape[1], S5_GROUPS, S5_CH)
    ul = ul.reshape(B, ul.shape[1], S5_GROUPS, S5_CH)
    zero = jnp.zeros((B, S5_GROUPS, S5_STATE), ul.dtype)
    y_l = d_skip * ul
    y_c = d_skip * uc if need_ctx_out else None
    for d, reverse in enumerate((False, True)):
        ab_re, ab_im, bb_re, bb_im = zoh_discretise(lam_re[d], lam_im[d], log_dt[d], b_re[d], b_im[d])
        sc_re, sc_im, fc_re, fc_im = diag_scan(ab_re, ab_im, bb_re, bb_im, uc, zero, zero, reverse)
        sl_re, sl_im, _, _ = diag_scan(ab_re, ab_im, bb_re, bb_im, ul, fc_re, fc_im, reverse)
        y_l = y_l + ssm_readout(c_re[d], c_im[d], sl_re, sl_im)
        if need_ctx_out:
            y_c = y_c + ssm_readout(c_re[d], c_im[d], sc_re, sc_im)
    out_l = s5_glu(y_l, glu_w, glu_b).reshape(B, -1, S5_W)
    out_c = s5_glu(y_c, glu_w, glu_b).reshape(B, -1, S5_W) if need_ctx_out else None
    return out_c, out_l


def mixer(hc, hl, w_in, w_out, q_norm, k_norm, attn_out_norm, ssm_out_norm, pool_w, pool_scale, s5_params, cos, sin, need_ctx_out):
    pc = jnp.split(hc @ w_in, SPLITS, axis=-1)
    pl = jnp.split(hl @ w_in, SPLITS, axis=-1)
    attn_c, attn_l = attention_branch(pc[:3], pl[:3], q_norm, k_norm, cos, sin, need_ctx_out)
    ssm_c, ssm_l = s5_branch(pc[4], pl[4], *s5_params, need_ctx_out)

    def merge(a, p, s):
        return jnp.concatenate([rmsnorm(a, attn_out_norm), p, rmsnorm(s, ssm_out_norm)], axis=-1) @ w_out

    out_l = merge(attn_l, pool_branch(pl[3], pool_w, pool_scale), ssm_l)
    out_c = merge(attn_c, pool_branch(pc[3], pool_w, pool_scale), ssm_c) if need_ctx_out else None
    return out_c, out_l


def setup_inputs(seed: int = 0) -> dict:
    key = jax.random.key(seed)
    ks = jax.random.split(key, 32)
    D = D_MODEL
    G, H, P = S5_GROUPS, S5_CH, S5_STATE

    def nrm(k, shape, s):
        return jax.random.normal(k, shape, jnp.float32) * s

    lam_im_base = math.pi * jnp.arange(P, dtype=jnp.float32)
    return {
        'x': nrm(ks[0], (BATCH, SEQ, D), 1.0),
        'c': nrm(ks[1], (BATCH, D), 1.0),
        'ctx': nrm(ks[2], (BATCH, CTX_LEN, D), 1.0),
        'c_ctx': nrm(ks[3], (D,), 1.0),
        'w_ada': nrm(ks[4], (DEPTH, D, N_MOD * D), 0.5 * D ** -0.5),
        'b_ada': nrm(ks[5], (DEPTH, N_MOD * D), 0.02),
        'norm_sub': 1.0 + nrm(ks[6], (DEPTH, 3, D), 0.02),
        'w_ffn_gate': nrm(ks[7], (DEPTH, 2, D, D_FF), D ** -0.5),
        'w_ffn_up': nrm(ks[8], (DEPTH, 2, D, D_FF), D ** -0.5),
        'w_ffn_down': nrm(ks[9], (DEPTH, 2, D_FF, D), D_FF ** -0.5),
        'w_in': nrm(ks[10], (DEPTH, D, IN_W), D ** -0.5),
        'w_out': nrm(ks[11], (DEPTH, MIX_W, D), MIX_W ** -0.5),
        'q_norm': 1.0 + nrm(ks[12], (DEPTH, HEAD_DIM), 0.02),
        'k_norm': 1.0 + nrm(ks[13], (DEPTH, HEAD_DIM), 0.02),
        'attn_out_norm': 1.0 + nrm(ks[14], (DEPTH, ATTN_W), 0.02),
        'ssm_out_norm': 1.0 + nrm(ks[15], (DEPTH, S5_W), 0.02),
        'pool_w': nrm(ks[16], (DEPTH, len(POOL_WINDOWS), POOL_CH, POOL_CH), POOL_CH ** -0.5),
        'pool_scale': 1.0 + nrm(ks[17], (DEPTH, POOL_W), 0.1),
        's5_lam_re': -0.5 + nrm(ks[18], (DEPTH, 2, G, P), 0.01),
        's5_lam_im': lam_im_base + nrm(ks[19], (DEPTH, 2, G, P), 0.01),
        's5_log_dt': jax.random.uniform(ks[20], (DEPTH, 2, G), jnp.float32, math.log(S5_DT_MIN), math.log(S5_DT_MAX)),
        's5_b_re': nrm(ks[21], (DEPTH, 2, G, P, H), (2 * H) ** -0.5),
        's5_b_im': nrm(ks[22], (DEPTH, 2, G, P, H), (2 * H) ** -0.5),
        's5_c_re': nrm(ks[23], (DEPTH, 2, G, H, P), P ** -0.5),
        's5_c_im': nrm(ks[24], (DEPTH, 2, G, H, P), P ** -0.5),
        's5_d': nrm(ks[25], (DEPTH, G, H), 0.5),
        's5_glu_w': nrm(ks[26], (DEPTH, G, H, H), H ** -0.5),
        's5_glu_b': nrm(ks[27], (DEPTH, G, H), 0.02),
        'final_norm': 1.0 + nrm(ks[28], (D,), 0.02),
    }


def reference(x, c, ctx, c_ctx, w_ada, b_ada, norm_sub, w_ffn_gate, w_ffn_up, w_ffn_down, w_in, w_out, q_norm, k_norm, attn_out_norm, ssm_out_norm, pool_w, pool_scale, s5_lam_re, s5_lam_im, s5_log_dt, s5_b_re, s5_b_im, s5_c_re, s5_c_im, s5_d, s5_glu_w, s5_glu_b, final_norm):
    ROWS = x.shape[1] // GRID_W
    cos, sin = axial_rope_tables(ROWS)
    z = ctx
    for l in range(DEPTH):
        need_ctx_out = l < DEPTH - 1
        mx = adaln(c, w_ada[l], b_ada[l])
        mz = adaln(c_ctx, w_ada[l], b_ada[l])
        ffn1 = (w_ffn_gate[l, 0], w_ffn_up[l, 0], w_ffn_down[l, 0])
        ffn2 = (w_ffn_gate[l, 1], w_ffn_up[l, 1], w_ffn_down[l, 1])
        x = x + 0.5 * mx[2] * swiglu(modulate(x, norm_sub[l, 0], mx[0], mx[1]), *ffn1)
        z = z + 0.5 * mz[2] * swiglu(modulate(z, norm_sub[l, 0], mz[0], mz[1]), *ffn1)
        s5_params = (s5_lam_re[l], s5_lam_im[l], s5_log_dt[l], s5_b_re[l], s5_b_im[l], s5_c_re[l], s5_c_im[l], s5_d[l], s5_glu_w[l], s5_glu_b[l])
        out_c, out_l = mixer(modulate(z, norm_sub[l, 1], mz[3], mz[4]), modulate(x, norm_sub[l, 1], mx[3], mx[4]), w_in[l], w_out[l], q_norm[l], k_norm[l], attn_out_norm[l], ssm_out_norm[l], pool_w[l], pool_scale[l], s5_params, cos, sin, need_ctx_out)
        x = x + mx[5] * out_l
        x = x + 0.5 * mx[8] * swiglu(modulate(x, norm_sub[l, 2], mx[6], mx[7]), *ffn2)
        if need_ctx_out:
            z = z + mz[5] * out_c
            z = z + 0.5 * mz[8] * swiglu(modulate(z, norm_sub[l, 2], mz[6], mz[7]), *ffn2)
    return rmsnorm(x, final_norm)
```

```cpp
#include <hip/hip_runtime.h>
#include <hip/hip_cooperative_groups.h>
#include <cstdio>
#include <cstdint>
namespace cg = cooperative_groups;
namespace pg8 {
#define PG8_LAS __attribute__((address_space(3)))
typedef unsigned short bf16_t;
typedef short bf16x8 __attribute__((ext_vector_type(8)));
typedef float f32x4 __attribute__((ext_vector_type(4)));
typedef unsigned u32x4 __attribute__((ext_vector_type(4)));
constexpr int BM = 256, BK = 64, HALF = 128, HTB = HALF * BK * 2  , STAGE_BYTES = 8 * HTB, NXCD = 8, WGM = 8;

__host__ __device__ __forceinline__ int lds_byte(int r, int c) { const int st = (r >> 4) * 2 + (c >> 5), rr = r & 15, cc = c & 31, ob = rr * 64 + cc * 2; return st * 1024 + (ob ^ (((ob >> 9) & 1) << 5)); }
__host__ __device__ __forceinline__ void stage_rc(int b, int& R, int& C) { const int st = b / 1024, sb = b % 1024, swz = sb ^ (((sb >> 9) & 1) << 5); R = (st >> 1) * 16 + swz / 64; C = (st & 1) * 32 + (swz % 64) / 2; }
__host__ __device__ __forceinline__ int perm32(int rho) { const int n = rho >> 4, i = rho & 15; return 8 * (i >> 2) + 4 * n + (i & 3); }

struct Unit { int pm, pn; int k0 = 0; int nt = 0; };
struct Gemm { const bf16_t* A; const bf16_t* Bt; int M, N, K; int nt; };

struct StaticOrder {
    int nM, nN, nwg, G, c;
    __host__ __device__ void init(int M, int N, int G_, int c_) { nM = M / BM; nN = N / BM; nwg = nM * nN; G = G_; c = c_; }
    __host__ __device__ bool next(int i, Unit& u) const {
        const long L = (long)i * G + c; if (L >= nwg) return false;
        int wgid = (int)L; { const int q = nwg / NXCD, r = nwg % NXCD, xcd = wgid % NXCD, off = wgid / NXCD; wgid = (xcd < r ? xcd * (q + 1) : r * (q + 1) + (xcd - r) * q) + off; }
        const int nig = WGM * nN, gid = wgid / nig, fm = gid * WGM, gsz = (nM - fm) < WGM ? (nM - fm) : WGM;
        u.pm = fm + ((wgid % nig) % gsz); u.pn = (wgid % nig) / gsz; return true;
    }
    __device__ __forceinline__ void a_ready(const Unit&) const {}
    __device__ __forceinline__ void done(const Unit&) const {}
};

__device__ __forceinline__ unsigned cvt_pk_bf16(float lo, float hi) { unsigned r; asm volatile("v_cvt_pk_bf16_f32 %0, %1, %2" : "=v"(r) : "v"(lo), "v"(hi)); return r; }

template <class Epi, class Sched, bool ALIGN_EPI = false, bool SP2 = false>
__device__ __forceinline__ void gemm_phase(PG8_LAS unsigned char* lds, const Gemm g, const Sched& S, const Epi& E, const int tid) {
    const int wid = __builtin_amdgcn_readfirstlane(tid >> 6), lane = tid & 63, wr = wid >> 2, wc = wid & 3, fr = lane & 15, fq = lane >> 4;
    const int K = g.K;
    unsigned voffA[2], voffB[2];
#pragma unroll
    for (int i = 0; i < 2; ++i) { int R, C; stage_rc(tid * 16 + i * 8192, R, C); const int Rb = Epi::PERM ? ((R & ~31) + perm32(R & 31)) : R;
        voffA[i] = (unsigned)(R * K + C) * 2u; voffB[i] = (unsigned)(Rb * K + C) * 2u; }
    const size_t kstep = (size_t)(BK * 2);
    const size_t hstep = (size_t)HALF * K * 2;
    const size_t tstep = 2 * hstep;
    const unsigned ldsw = (unsigned)wid * 1024u;
    const int aoff = lds_byte(wr * 64 + fr, fq * 8), boff = lds_byte(wc * 32 + fr, fq * 8);
#define PG8_SA(b, h) (((b) * 2 + (h)) * HTB)
#define PG8_SB(b, h) ((4 + (b) * 2 + (h)) * HTB)
#define PG8_STAGE(bufoff, gbase, voff) do { _Pragma("unroll") for (int _i = 0; _i < 2; ++_i) \
        __builtin_amdgcn_global_load_lds((const unsigned*)((const char*)(gbase) + (voff)[_i]), (PG8_LAS unsigned*)(lds + (bufoff) + ldsw + _i * 8192), 16, 0, 0); } while (0)
#define PG8_LDA(dst, b, h) do { _Pragma("unroll") for (int m = 0; m < 4; ++m) _Pragma("unroll") for (int k = 0; k < 2; ++k) dst[m][k] = *(const PG8_LAS bf16x8*)(lds + PG8_SA(b, h) + aoff + m * 2048 + k * 1024); } while (0)
#define PG8_LDB(dst, b, h) do { _Pragma("unroll") for (int n = 0; n < 2; ++n) _Pragma("unroll") for (int k = 0; k < 2; ++k) dst[n][k] = *(const PG8_LAS bf16x8*)(lds + PG8_SB(b, h) + boff + n * 2048 + k * 1024); } while (0)
#define PG8_MMA(ai, bj, At, Bt) do { __builtin_amdgcn_s_setprio(1); _Pragma("unroll") for (int m = 0; m < 4; ++m) _Pragma("unroll") for (int n = 0; n < 2; ++n) _Pragma("unroll") for (int k = 0; k < 2; ++k) \
        acc[ai][bj][m][n] = __builtin_amdgcn_mfma_f32_16x16x32_bf16(Bt[n][k], At[m][k], acc[ai][bj][m][n], 0, 0, 0); __builtin_amdgcn_s_setprio(0); } while (0)
#define PG8_WAIT_V(n) asm volatile("s_waitcnt vmcnt(" #n ")" ::: "memory")
#define PG8_WAIT_L(n) asm volatile("s_waitcnt lgkmcnt(" #n ")" ::: "memory")
#define PG8_BAR __builtin_amdgcn_s_barrier()
#define PG8_SCHED __builtin_amdgcn_sched_barrier(0)
    Unit cur, nxt; int ui = 0;
    if (!S.next(0, cur)) return;
    f32x4 acc[2][2][4][2];
#pragma unroll
    for (int a = 0; a < 2; ++a)
#pragma unroll
        for (int b = 0; b < 2; ++b)
#pragma unroll
            for (int m = 0; m < 4; ++m)
#pragma unroll
                for (int n = 0; n < 2; ++n) acc[a][b][m][n] = (f32x4){0.f, 0.f, 0.f, 0.f};
    bf16x8 At[4][2], B0[2][2], B1[2][2];
    const char* cA = (const char*)g.A + (size_t)cur.pm * tstep + (size_t)cur.k0 * 2; const char* cB = (const char*)g.Bt + (size_t)cur.pn * tstep + (size_t)cur.k0 * 2;
    S.a_ready(cur);
    if constexpr (SP2) {
        PG8_STAGE(PG8_SB(0, 0), cB, voffB); PG8_STAGE(PG8_SB(0, 1), cB + hstep, voffB); PG8_STAGE(PG8_SA(0, 0), cA, voffA); PG8_STAGE(PG8_SA(0, 1), cA + hstep, voffA);
        if (wr == 1) PG8_BAR;
        PG8_WAIT_V(2); PG8_BAR;
        PG8_STAGE(PG8_SB(1, 0), cB + kstep, voffB); PG8_STAGE(PG8_SA(1, 0), cA + kstep, voffA); PG8_STAGE(PG8_SB(1, 1), cB + hstep + kstep, voffB);
        PG8_WAIT_V(6); PG8_BAR;
    } else {
        PG8_STAGE(PG8_SB(0, 0), cB, voffB); PG8_STAGE(PG8_SA(0, 0), cA, voffA); PG8_STAGE(PG8_SB(0, 1), cB + hstep, voffB); PG8_STAGE(PG8_SA(0, 1), cA + hstep, voffA);
        if (wr == 1) PG8_BAR;
        PG8_WAIT_V(4); PG8_BAR;
        PG8_STAGE(PG8_SB(1, 0), cB + kstep, voffB); PG8_STAGE(PG8_SA(1, 0), cA + kstep, voffA); PG8_STAGE(PG8_SB(1, 1), cB + hstep + kstep, voffB);
        PG8_WAIT_V(6); PG8_BAR;
    }
    for (;;) {
        const bool has_next = S.next(ui + 1, nxt);
        const int nt = cur.nt ? cur.nt : g.nt;
        const char* nA = has_next ? (const char*)g.A + (size_t)nxt.pm * tstep + (size_t)nxt.k0 * 2 : cA; const char* nB = has_next ? (const char*)g.Bt + (size_t)nxt.pn * tstep + (size_t)nxt.k0 * 2 : cB;
        for (int t = 0; t < nt; t += 2) {
            const bool last = (t == nt - 2);
            const char* a1 = cA + (size_t)(t + 1) * kstep;
            const char* a2 = last ? nA : cA + (size_t)(t + 2) * kstep; const char* b2 = last ? nB : cB + (size_t)(t + 2) * kstep;
            const char* a3 = a2 + kstep; const char* b3 = b2 + kstep;
            if (last && has_next) S.a_ready(nxt);
            if constexpr (SP2) {
            PG8_LDB(B0, 0, 0); PG8_LDB(B1, 0, 1); PG8_SCHED; PG8_LDA(At, 0, 0); PG8_STAGE(PG8_SA(1, 1), a1 + hstep, voffA);
            PG8_WAIT_V(8); PG8_WAIT_L(0); PG8_BAR; PG8_MMA(0, 0, At, B0); PG8_MMA(0, 1, At, B1); PG8_BAR; PG8_SCHED;
            PG8_LDA(At, 0, 1); PG8_STAGE(PG8_SB(0, 0), b2, voffB); PG8_STAGE(PG8_SB(0, 1), b2 + hstep, voffB); PG8_STAGE(PG8_SA(0, 0), a2, voffA);
            PG8_WAIT_V(8); PG8_WAIT_L(0); PG8_BAR; PG8_MMA(1, 0, At, B0); PG8_MMA(1, 1, At, B1); PG8_BAR; PG8_SCHED;
            PG8_LDB(B0, 1, 0); PG8_LDB(B1, 1, 1); PG8_SCHED; PG8_LDA(At, 1, 0); PG8_STAGE(PG8_SA(0, 1), a2 + hstep, voffA);
            PG8_WAIT_V(8); PG8_WAIT_L(0); PG8_BAR; PG8_MMA(0, 0, At, B0); PG8_MMA(0, 1, At, B1); PG8_BAR; PG8_SCHED;
            PG8_LDA(At, 1, 1); PG8_STAGE(PG8_SB(1, 0), b3, voffB); PG8_STAGE(PG8_SB(1, 1), b3 + hstep, voffB); PG8_STAGE(PG8_SA(1, 0), a3, voffA);
            PG8_WAIT_V(8); PG8_WAIT_L(0); PG8_BAR; PG8_MMA(1, 0, At, B0); PG8_MMA(1, 1, At, B1); PG8_BAR; PG8_SCHED;
            } else {
            PG8_LDB(B0, 0, 0); PG8_SCHED; PG8_LDA(At, 0, 0); PG8_STAGE(PG8_SA(1, 1), a1 + hstep, voffA);
            PG8_WAIT_L(8); PG8_BAR; PG8_WAIT_L(0); PG8_MMA(0, 0, At, B0); PG8_BAR; PG8_SCHED;
            PG8_LDB(B1, 0, 1); PG8_STAGE(PG8_SB(0, 0), b2, voffB);
            PG8_BAR; PG8_WAIT_L(0); PG8_MMA(0, 1, At, B1); PG8_BAR;
            PG8_LDA(At, 0, 1); PG8_STAGE(PG8_SA(0, 0), a2, voffA);
            PG8_BAR; PG8_WAIT_L(0); PG8_MMA(1, 0, At, B0); PG8_BAR; PG8_SCHED;
            PG8_STAGE(PG8_SB(0, 1), b2 + hstep, voffB);
            PG8_WAIT_V(6); PG8_BAR; PG8_MMA(1, 1, At, B1); PG8_BAR;
            PG8_LDB(B0, 1, 0); PG8_SCHED; PG8_LDA(At, 1, 0); PG8_STAGE(PG8_SA(0, 1), a2 + hstep, voffA);
            PG8_WAIT_L(8); PG8_BAR; PG8_WAIT_L(0); PG8_MMA(0, 0, At, B0); PG8_BAR; PG8_SCHED;
            PG8_LDB(B1, 1, 1); PG8_STAGE(PG8_SB(1, 0), b3, voffB);
            PG8_BAR; PG8_WAIT_L(0); PG8_MMA(0, 1, At, B1); PG8_BAR;
            PG8_LDA(At, 1, 1); PG8_STAGE(PG8_SA(1, 0), a3, voffA);
            PG8_BAR; PG8_WAIT_L(0); PG8_MMA(1, 0, At, B0); PG8_BAR; PG8_SCHED;
            PG8_STAGE(PG8_SB(1, 1), b3 + hstep, voffB);
            PG8_WAIT_V(6); PG8_BAR; PG8_MMA(1, 1, At, B1); PG8_BAR;
            }
        }
        if constexpr (ALIGN_EPI) { if (wr == 0) PG8_BAR; }
        if constexpr (!Epi::AFTER_DRAIN) { E(acc, cur, wr, wc, fr, fq); S.done(cur); }
        if (!has_next) break;
#pragma unroll
        for (int a = 0; a < 2; ++a)
#pragma unroll
            for (int b = 0; b < 2; ++b)
#pragma unroll
                for (int m = 0; m < 4; ++m)
#pragma unroll
                    for (int n = 0; n < 2; ++n) acc[a][b][m][n] = (f32x4){0.f, 0.f, 0.f, 0.f};
        cur = nxt; cA = nA; cB = nB; ++ui;
        if constexpr (ALIGN_EPI) { if (wr == 1) PG8_BAR; }
    }
    PG8_WAIT_V(0);
    if constexpr (!ALIGN_EPI) { if (wr == 0) PG8_BAR; }
    PG8_BAR;
    if constexpr (Epi::AFTER_DRAIN) { E.fused(acc, cur, wr, wc, fr, fq, lds, wid, lane); S.done(cur); }
#undef PG8_SA
#undef PG8_SB
#undef PG8_STAGE
#undef PG8_LDA
#undef PG8_LDB
#undef PG8_MMA
#undef PG8_WAIT_V
#undef PG8_WAIT_L
#undef PG8_BAR
#undef PG8_SCHED
}
}
#define LAS __attribute__((address_space(3)))
typedef unsigned short bf16_t;
typedef short bf16x8 __attribute__((ext_vector_type(8)));
typedef float f32x4 __attribute__((ext_vector_type(4)));
typedef float f32x2 __attribute__((ext_vector_type(2)));
typedef float f32x16 __attribute__((ext_vector_type(16)));
typedef unsigned u32x4 __attribute__((ext_vector_type(4)));
typedef unsigned u32x2 __attribute__((ext_vector_type(2)));
typedef __bf16 bf16x2_t __attribute__((ext_vector_type(2)));

constexpr int DM = 1024, NB = 4, SEQ = 4096, CTX = 256, RPB = SEQ + CTX  , MROWS = NB * RPB  ;
constexpr int DFF = 2816, INW = 1280, NMOD = 9, DEPTH = 4, NRB = RPB / 256  ;
constexpr float EPS = 1e-6f;
constexpr float C2 = 0.125f * 1.4426950408889634f;
constexpr int LDS_BYTES = 147456;

constexpr size_t al256(size_t x) { return (x + 255) & ~(size_t)255; }
constexpr size_t WS_WGU = 0;
constexpr size_t WS_WD = WS_WGU + al256((size_t)DEPTH * 2 * 5632 * 1024 * 2);
constexpr size_t WS_WIN = WS_WD + al256((size_t)DEPTH * 2 * 1024 * 2816 * 2);
constexpr size_t WS_WOUT = WS_WIN + al256((size_t)DEPTH * 1280 * 1024 * 2);
constexpr size_t WS_MODS = WS_WOUT + al256((size_t)DEPTH * 1024 * 1024 * 2);
constexpr size_t WS_X = WS_MODS + al256((size_t)DEPTH * 5 * 9216 * 4);
constexpr size_t WS_A = WS_X + al256((size_t)MROWS * 1024 * 4);
constexpr size_t WS_H = WS_A + al256((size_t)MROWS * 1024 * 2);
constexpr size_t WS_P = WS_H + al256((size_t)MROWS * DFF * 2);
constexpr size_t WS_Q = WS_P + al256((size_t)MROWS * INW * 2);
constexpr size_t WS_K = WS_Q + al256((size_t)MROWS * 512 * 2);
constexpr size_t WS_VT = WS_K + al256((size_t)NB * 2 * RPB * 64 * 2);
constexpr size_t WS_O = WS_VT + al256((size_t)NB * 2 * RPB * 64 * 2);
constexpr size_t WS_SSMO = WS_O + al256((size_t)MROWS * 512 * 2);
constexpr size_t WS_WE = WS_SSMO + al256((size_t)MROWS * 256 * 4);
constexpr size_t WS_WC = WS_WE + al256((size_t)DEPTH * 2 * 16 * 128 * 256 * 2);
constexpr size_t WS_KC = WS_WC + al256((size_t)DEPTH * 2 * 16 * 16 * 16 * 128 * 2);
constexpr size_t WS_A16 = WS_KC + al256((size_t)DEPTH * 16 * 31 * 256 * 2);
constexpr size_t WS_A256 = WS_A16 + al256((size_t)DEPTH * 2 * 16 * 64 * 8);
constexpr size_t WS_EB = WS_A256 + al256((size_t)DEPTH * 2 * 16 * 64 * 8);
constexpr size_t WS_BAR = WS_EB + al256((size_t)NB * 2 * 16 * NRB * 128 * 4);
constexpr size_t WS_PART = WS_BAR + 16384;
constexpr size_t WS_SPL = WS_PART + (size_t)11 * 1024 * 1024 * 4;
constexpr size_t WS_END = WS_SPL + (size_t)NB * 2 * 16 * NRB * 16 * 128 * 2;
constexpr int LDS_ST_OFF = 147200;

struct Params { const float* in[29]; float* out; unsigned char* ws; };

__device__ __forceinline__ float bf2f(unsigned short h) { return __builtin_bit_cast(float, (unsigned)h << 16); }
__device__ __forceinline__ unsigned pk2(float lo, float hi) { f32x2 v = {lo, hi}; bf16x2_t b = __builtin_convertvector(v, bf16x2_t); return __builtin_bit_cast(unsigned, b); }
__device__ __forceinline__ unsigned short f2bf(float f) { return (unsigned short)(pk2(f, 0.f) & 0xffffu); }
__device__ __forceinline__ float shx(float v, int mask, int lane) { return __builtin_bit_cast(float, __builtin_amdgcn_ds_bpermute((lane ^ mask) << 2, __builtin_bit_cast(int, v))); }
__device__ __forceinline__ float wave_sum(float v, int lane) {
#pragma unroll
    for (int o = 1; o < 64; o <<= 1) v += shx(v, o, lane);
    return v;
}
__device__ __forceinline__ int hw_lane() { int l; asm volatile("v_mbcnt_lo_u32_b32 %0, -1, 0\n\tv_mbcnt_hi_u32_b32 %0, -1, %0" : "=v"(l)); return l; }
#define LDS_WAIT() asm volatile("s_waitcnt lgkmcnt(0)" ::: "memory")
__device__ __forceinline__ float fast_exp2(float x) { return __builtin_amdgcn_exp2f(x); }
__device__ __forceinline__ float fast_rcp(float x) { return __builtin_amdgcn_rcpf(x); }
__device__ __forceinline__ float sigmoidf_(float x) { return fast_rcp(1.f + fast_exp2(-1.4426950408889634f * x)); }
__device__ __forceinline__ float siluf_(float x) { return x * sigmoidf_(x); }
__device__ __forceinline__ void cossin_rev(double rev, float& c, float& s) {
    rev -= __builtin_rint(rev); const float fr = (float)rev; c = __builtin_amdgcn_cosf(fr); s = __builtin_amdgcn_sinf(fr);
}

using pg8::Unit;
struct EpiSwiGLU {
    static constexpr bool PERM = true, AFTER_DRAIN = false;
    bf16_t* H;
    __device__ __forceinline__ void operator()(const f32x4 (&acc)[2][2][4][2], const Unit& u, int wr, int wc, int fr, int fq) const {
        const int row0 = u.pm * 256 + wr * 64 + fr, col0 = u.pn * 128 + wc * 32 + 8 * fq;
#pragma unroll
        for (int ai = 0; ai < 2; ++ai)
#pragma unroll
            for (int m = 0; m < 4; ++m) {
                bf16_t* rowp = H + (size_t)(row0 + ai * 128 + m * 16) * DFF + col0;
                float h[8];
#pragma unroll
                for (int n = 0; n < 2; ++n)
#pragma unroll
                    for (int j = 0; j < 4; ++j) h[4 * n + j] = siluf_(acc[ai][0][m][n][j]) * acc[ai][1][m][n][j];
                u32x4 w; w.x = pk2(h[0], h[1]); w.y = pk2(h[2], h[3]); w.z = pk2(h[4], h[5]); w.w = pk2(h[6], h[7]);
                *(u32x4*)rowp = w;
            }
    }
};
struct EpiP {
    static constexpr bool PERM = true, AFTER_DRAIN = false;
    bf16_t* P;
    __device__ __forceinline__ void operator()(const f32x4 (&acc)[2][2][4][2], const Unit& u, int wr, int wc, int fr, int fq) const {
        const int row0 = u.pm * 256 + wr * 64 + fr, col0 = u.pn * 256 + wc * 32 + 8 * fq;
#pragma unroll
        for (int ai = 0; ai < 2; ++ai)
#pragma unroll
            for (int m = 0; m < 4; ++m)
#pragma unroll
                for (int bj = 0; bj < 2; ++bj) {
                    const f32x4 v0 = acc[ai][bj][m][0], v1 = acc[ai][bj][m][1];
                    u32x4 w; w.x = pk2(v0[0], v0[1]); w.y = pk2(v0[2], v0[3]); w.z = pk2(v1[0], v1[1]); w.w = pk2(v1[2], v1[3]);
                    *(u32x4*)(P + (size_t)(row0 + ai * 128 + m * 16) * INW + col0 + bj * 128) = w;
                }
    }
};
struct EpiResid {
    static constexpr bool PERM = true, AFTER_DRAIN = false;
    float* X; const float* modl; int goff; float coef;
    __device__ __forceinline__ void operator()(const f32x4 (&acc)[2][2][4][2], const Unit& u, int wr, int wc, int fr, int fq) const {
        const int row0 = u.pm * 256 + wr * 64 + fr;
        const int b = u.pm / NRB, mi = (u.pm % NRB == 0) ? 4 : b;
        const float* gp = modl + (size_t)mi * (NMOD * DM) + goff + u.pn * 256 + wc * 32 + 8 * fq;
        f32x4 gv[2][2];
#pragma unroll
        for (int bj = 0; bj < 2; ++bj)
#pragma unroll
            for (int n = 0; n < 2; ++n) gv[bj][n] = *(const f32x4*)(gp + bj * 128 + 4 * n) * coef;
#pragma unroll
        for (int ai = 0; ai < 2; ++ai)
#pragma unroll
            for (int m = 0; m < 4; ++m) {
                float* rp = X + (size_t)(row0 + ai * 128 + m * 16) * DM + u.pn * 256 + wc * 32 + 8 * fq;
#pragma unroll
                for (int bj = 0; bj < 2; ++bj)
#pragma unroll
                    for (int n = 0; n < 2; ++n) { f32x4* p = (f32x4*)(rp + bj * 128 + 4 * n); f32x4 x = *p; x += gv[bj][n] * acc[ai][bj][m][n]; *p = x; }
            }
    }
};

struct EpiResidBoth {
    static constexpr bool PERM = true, AFTER_DRAIN = false;
    float* X; float* PART; const float* modl; int goff; float coef; const float* xin  ;
    __device__ __forceinline__ void operator()(const f32x4 (&acc)[2][2][4][2], const Unit& u, int wr, int wc, int fr, int fq) const {
        const int b = u.pm / NRB; const bool isctx = (u.pm % NRB == 0); const int mi = isctx ? 4 : b;
        const float* gp = modl + (size_t)mi * (NMOD * DM) + goff + u.pn * 256 + wc * 32 + 8 * fq;
        f32x4 gv[2][2];
#pragma unroll
        for (int bj = 0; bj < 2; ++bj)
#pragma unroll
            for (int n = 0; n < 2; ++n) gv[bj][n] = *(const f32x4*)(gp + bj * 128 + 4 * n) * coef;
        float* base = X + (size_t)(u.pm * 256 + wr * 64 + fr) * DM;
        base += u.pn * 256 + wc * 32 + 8 * fq;
        if (isctx) {
            bf16_t* pb = (bf16_t*)PART + ((size_t)(u.k0 >> 8) * 1024 + b * 256 + wr * 64 + fr) * DM + u.pn * 256 + wc * 32 + 8 * fq;
#pragma unroll
            for (int ai = 0; ai < 2; ++ai)
#pragma unroll
                for (int m = 0; m < 4; ++m)
#pragma unroll
                    for (int bj = 0; bj < 2; ++bj) { const f32x4 v0 = gv[bj][0] * acc[ai][bj][m][0], v1 = gv[bj][1] * acc[ai][bj][m][1];
                        u32x4 w; w.x = pk2(v0[0], v0[1]); w.y = pk2(v0[2], v0[3]); w.z = pk2(v1[0], v1[1]); w.w = pk2(v1[2], v1[3]);
                        *(u32x4*)(pb + (size_t)(ai * 128 + m * 16) * DM + bj * 128) = w; }
            return;
        }
        const float* rbase = (xin != nullptr && !isctx) ? xin + (size_t)(u.pm * 256 + wr * 64 + fr - (b + 1) * CTX) * DM + u.pn * 256 + wc * 32 + 8 * fq : base;
#pragma unroll
        for (int ai = 0; ai < 2; ++ai)
#pragma unroll
            for (int m = 0; m < 4; ++m) {
                float* rp = base + (size_t)(ai * 128 + m * 16) * DM; const float* rr = rbase + (size_t)(ai * 128 + m * 16) * DM;
#pragma unroll
                for (int bj = 0; bj < 2; ++bj)
#pragma unroll
                    for (int n = 0; n < 2; ++n) { f32x4 v = gv[bj][n] * acc[ai][bj][m][n]; if (!isctx) v += *(const f32x4*)(rr + bj * 128 + 4 * n); *(f32x4*)(rp + bj * 128 + 4 * n) = v; }
            }
    }
};
struct ResidOrder {
    pg8::StaticOrder S; int nS, G, c;
    __device__ void init(int K, int G_, int c_, bool noctx) { S.init(NB * SEQ, 1024, G_, c_); nS = noctx ? 0 : K / 256; G = G_; c = c_; }
    __device__ bool next(int i, Unit& u) const {
        const int idx = i * G + c;
        if (idx < 256) { S.next(i, u); u.pm = u.pm + (u.pm >> 4) + 1; u.k0 = 0; u.nt = 0; return true; }
        const int L = idx - 256; if (L >= 16 * nS) return false;
        const int ks = L >> 4, r = L & 15; u.pm = (r >> 2) * NRB; u.pn = r & 3; u.k0 = ks * 256; u.nt = 4; return true; }
    __device__ __forceinline__ void a_ready(const Unit&) const {}
    __device__ __forceinline__ void done(const Unit&) const {}
};
#define XB_TMO      128
#define XB_XCNT(j)  (256  + 64 * (j))
#define XB_XSUB(j)  (1280 + 64 * (j))
#define XB_XGEN(j)  (2304 + 64 * (j))
#define XB_TOP      3328
#define XB_TOPGEN   3392
#define XCD_BAR_WORDS 3456
#define XB_SPIN_CAP (1u << 18)

__device__ __forceinline__ unsigned xb_ld(unsigned* p)              { return __hip_atomic_load(p, __ATOMIC_RELAXED, __HIP_MEMORY_SCOPE_AGENT); }
__device__ __forceinline__ unsigned xb_add(unsigned* p, unsigned v) { return __hip_atomic_fetch_add(p, v, __ATOMIC_RELAXED, __HIP_MEMORY_SCOPE_AGENT); }
__device__ __forceinline__ unsigned xb_xcc_id() { return (unsigned)__builtin_amdgcn_s_getreg((3 << 11) | 20) & 0xFu; }
#define XB_SPIN(cond, bar) do { unsigned _sp = 0; while (cond) { __builtin_amdgcn_s_sleep(1); \
    if ((++_sp & 255u) == 0u) { if (xb_ld(&(bar)[XB_TMO])) break; if (_sp > XB_SPIN_CAP) { atomicAdd(&(bar)[XB_TMO], 1u); break; } } } } while (0)

struct XcdBarrier {
    unsigned* bar; unsigned x;
    volatile LAS unsigned* st;
};

__device__ __forceinline__ XcdBarrier xcd_barrier_post(unsigned* bar, volatile LAS unsigned* st, int tid) {
    XcdBarrier b; b.bar = bar; b.x = xb_xcc_id(); b.st = st;
    if (tid == 0) (void)xb_add(&bar[XB_XCNT(b.x)], 1u);
    return b;
}
__device__ __forceinline__ void xcd_barrier_complete(unsigned* bar, unsigned x, unsigned& nloc, unsigned& nx) {
    const unsigned G = gridDim.x * gridDim.y * gridDim.z;
    unsigned sum, cnt, mine, sp = 0u;
    for (;;) {
        sum = 0u; cnt = 0u; mine = 0u;
#pragma unroll
        for (unsigned j = 0; j < 16; ++j) { const unsigned c = xb_ld(&bar[XB_XCNT(j)]); sum += c; cnt += (c > 0u) ? 1u : 0u; mine = (j == x) ? c : mine; }
        if (sum == G) break;
        __builtin_amdgcn_s_sleep(1);
        if ((++sp & 255u) == 0u) { if (xb_ld(&bar[XB_TMO])) break; if (sp > XB_SPIN_CAP) { atomicAdd(&bar[XB_TMO], 1u); break; } }
    }
    nloc = mine > 0u ? mine : 1u; nx = cnt > 0u ? cnt : 1u;
}

__device__ __forceinline__ void xcd_barrier(const XcdBarrier& b, int tid) {
    asm volatile("s_waitcnt vmcnt(0)" ::: "memory");
    __syncthreads();
    if (tid == 0) {
        unsigned* bar = b.bar;
        __builtin_amdgcn_s_waitcnt(0);
        unsigned nloc = b.st[0], nx = b.st[1];
        if (nloc == 0u) { xcd_barrier_complete(bar, b.x, nloc, nx); b.st[0] = nloc; b.st[1] = nx; }
        const unsigned old = xb_add(&bar[XB_XSUB(b.x)], 1u);
        const unsigned gen = old / nloc;
        if (old + 1u == (gen + 1u) * nloc) {
            __builtin_amdgcn_fence(__ATOMIC_RELEASE, "agent");
            asm volatile("s_waitcnt vmcnt(0)" ::: "memory");
            const unsigned og = xb_add(&bar[XB_TOP], 1u);
            const unsigned tg = og / nx;
            if (og + 1u == (tg + 1u) * nx) xb_add(&bar[XB_TOPGEN], 1u);
            else XB_SPIN(xb_ld(&bar[XB_TOPGEN]) == tg, bar);
            __builtin_amdgcn_fence(__ATOMIC_ACQUIRE, "agent");
            xb_add(&bar[XB_XGEN(b.x)], 1u);
            asm volatile("s_waitcnt vmcnt(0)" ::: "memory");
        } else {
            XB_SPIN(xb_ld(&bar[XB_XGEN(b.x)]) == gen, bar);
            __builtin_amdgcn_fence(__ATOMIC_ACQUIRE, "agent");
            asm volatile("s_waitcnt vmcnt(0)" ::: "memory");
        }
    }
    __syncthreads();
}

struct Ctx {
    const Params* p;
    LAS unsigned char* lds;
    int tid, lane, wave, G, bid;
    __device__ __forceinline__ const float* in(int i) const { return p->in[i]; }
    __device__ __forceinline__ float* out() const { return p->out; }
#define WSP(T, NAME, OFF) __device__ __forceinline__ T* NAME() const { return (T*)(p->ws + OFF); }
    WSP(bf16_t, WGU, WS_WGU) WSP(bf16_t, WD, WS_WD) WSP(bf16_t, WIN, WS_WIN) WSP(bf16_t, WOUT, WS_WOUT) WSP(bf16_t, A, WS_A) WSP(bf16_t, H, WS_H) WSP(bf16_t, P, WS_P)
    WSP(bf16_t, Q, WS_Q) WSP(bf16_t, Kb, WS_K) WSP(bf16_t, Vt, WS_VT) WSP(bf16_t, O, WS_O) WSP(bf16_t, WE, WS_WE) WSP(bf16_t, WC, WS_WC) WSP(bf16_t, KC, WS_KC)
    WSP(float, MODS, WS_MODS) WSP(float, X, WS_X) WSP(float, SSMO, WS_SSMO) WSP(float, EB, WS_EB) WSP(float, PART, WS_PART) WSP(bf16_t, SPL, WS_SPL) WSP(f32x2, A16, WS_A16) WSP(f32x2, A256, WS_A256)
#undef WSP
};
enum { I_X = 0, I_C, I_CTX, I_CCTX, I_WADA, I_BADA, I_NSUB, I_WG, I_WU, I_WDN, I_WIN, I_WOUT, I_QN, I_KN, I_AON, I_SON, I_PW, I_PS,
       I_LRE, I_LIM, I_LDT, I_BRE, I_BIM, I_CRE, I_CIM, I_SD, I_GW, I_GB, I_FN };

__device__ __forceinline__ void transpose_item(const float* W, int K, int N, bf16_t* WT, int kb, int n0, int drow0, LAS float* scr, int lane) {
    const int k0 = 64 * kb;
    float wv[32];
#pragma unroll
    for (int i = 0; i < 32; ++i) wv[i] = W[(size_t)(k0 + 2 * i + (lane >> 5)) * N + n0 + (lane & 31)];
#pragma unroll
    for (int i = 0; i < 32; ++i) scr[(2 * i + (lane >> 5)) * 33 + (lane & 31)] = wv[i];
    LDS_WAIT();
    const int c = lane & 7;
#pragma unroll
    for (int j = 0; j < 4; ++j) { const int n = (lane >> 3) + 8 * j; const LAS float* s = scr + (8 * c) * 33 + n;
        u32x4 o; o.x = pk2(s[0 * 33], s[1 * 33]); o.y = pk2(s[2 * 33], s[3 * 33]); o.z = pk2(s[4 * 33], s[5 * 33]); o.w = pk2(s[6 * 33], s[7 * 33]);
        *(u32x4*)(WT + (size_t)(drow0 + n) * K + k0 + 8 * c) = o; }
    LDS_WAIT();
}
constexpr int TR_PER_LAYER = 6 * 1408 + 640 + 512;
__device__ __forceinline__ void transpose_layer_item(const Ctx& c, int l, int r, LAS float* scr) {
    if (r < 6 * 1408) { const int mat = r / 1408, rr = r % 1408, type = mat >> 1, lf = l * 2 + (mat & 1);
        if (type < 2) { const int kb = rr / 88, n0 = (rr % 88) * 32;
            transpose_item((type == 0 ? c.in(I_WG) : c.in(I_WU)) + (size_t)lf * 1024 * DFF, 1024, DFF, c.WGU() + (size_t)lf * 5632 * 1024, kb, n0, (n0 >> 7) * 256 + (n0 & 127) + type * 128, scr, c.lane); }
        else { const int kb = rr / 32, n0 = (rr % 32) * 32;
            transpose_item(c.in(I_WDN) + (size_t)lf * DFF * 1024, DFF, 1024, c.WD() + (size_t)lf * 1024 * DFF, kb, n0, n0, scr, c.lane); }
    } else if (r < 6 * 1408 + 640) { const int rr = r - 6 * 1408, kb = rr / 40, n0 = (rr % 40) * 32;
        transpose_item(c.in(I_WIN) + (size_t)l * 1024 * INW, 1024, INW, c.WIN() + (size_t)l * INW * 1024, kb, n0, n0, scr, c.lane);
    } else { const int rr = r - 6 * 1408 - 640, kb = rr / 32, n0 = (rr % 32) * 32;
        transpose_item(c.in(I_WOUT) + (size_t)l * 1024 * 1024, 1024, 1024, c.WOUT() + (size_t)l * 1024 * 1024, kb, n0, n0, scr, c.lane); }
}
struct S5Lam { float lr, li, dt; };
__device__ __forceinline__ S5Lam s5_lam(const Ctx& c, int ldg, int p) { S5Lam r; r.lr = c.in(I_LRE)[ldg * 64 + p]; r.li = c.in(I_LIM)[ldg * 64 + p]; r.dt = expf(c.in(I_LDT)[ldg]); return r; }
__device__ __forceinline__ void s5_pow(const S5Lam& L, int n, float& re, float& im) {
    const float mag = __expf((float)n * L.lr * L.dt); float cs, sn;
    cossin_rev((double)n * (double)L.li * (double)L.dt * 0.15915494309189535, cs, sn); re = mag * cs; im = mag * sn;
}
__device__ __forceinline__ void s5_f(const S5Lam& L, float& fre, float& fim) {
    float are, aim; s5_pow(L, 1, are, aim); const float den = L.lr * L.lr + L.li * L.li;
    fre = ((are - 1.f) * L.lr + aim * L.li) / den; fim = (aim * L.lr - (are - 1.f) * L.li) / den;
}

__device__ __forceinline__ void phase_prep(const Ctx& c) {
    const int gtid = c.bid * 512 + c.tid, NT = c.G * 512;
    const int gw = c.wave * c.G + c.bid, NGW = c.G * 8;
    {
        LAS float* sl = (LAS float*)c.lds;
        LAS float* red = (LAS float*)(c.lds + 20480);
        for (int i = c.tid; i < 5 * 1024; i += 512) { const int ci = i >> 10, k = i & 1023; const float v = (ci < 4) ? c.in(I_C)[ci * 1024 + k] : c.in(I_CCTX)[k]; sl[i] = v / (1.f + __expf(-v)); }
        __syncthreads();
        for (int item = c.bid; item < DEPTH * 144; item += c.G) {
            const int l = item / 144, n = (item % 144) * 64 + c.lane;
            const float* wp = c.in(I_WADA) + ((size_t)l * 1024 + 128 * c.wave) * 9216 + n;
            float acc[5] = {0.f, 0.f, 0.f, 0.f, 0.f};
            for (int kk = 0; kk < 128; kk += 32) {
                float wv[32];
#pragma unroll
                for (int i = 0; i < 32; ++i) wv[i] = wp[(size_t)(kk + i) * 9216];
#pragma unroll
                for (int i = 0; i < 32; ++i)
#pragma unroll
                    for (int ci = 0; ci < 5; ++ci) acc[ci] += sl[ci * 1024 + 128 * c.wave + kk + i] * wv[i];
            }
#pragma unroll
            for (int ci = 0; ci < 5; ++ci) red[(c.wave * 5 + ci) * 64 + c.lane] = acc[ci];
            __syncthreads();
            if (c.tid < 320) { const int ci = c.tid >> 6, ln = c.tid & 63; float s = 0.f;
#pragma unroll
                for (int w = 0; w < 8; ++w) s += red[(w * 5 + ci) * 64 + ln];
                const int nn = (item % 144) * 64 + ln; c.MODS()[((size_t)l * 5 + ci) * 9216 + nn] = s + c.in(I_BADA)[l * 9216 + nn]; }
            __syncthreads();
        }
    }
    { LAS float* scr = (LAS float*)(c.lds + 32768 + c.wave * 8704);
        for (int it = gw; it < TR_PER_LAYER; it += NGW) transpose_layer_item(c, 0, it, scr); }
    for (int ri = gw; ri < NB * CTX; ri += NGW) {
        const int b = ri >> 8, j = ri & 255;
        const f32x4* src = (const f32x4*)(c.in(I_CTX) + ((size_t)b * CTX + j) * DM) + c.lane; f32x4* dst = (f32x4*)(c.X() + ((size_t)b * RPB + j) * DM) + c.lane;
#pragma unroll
        for (int k = 0; k < 4; ++k) dst[64 * k] = src[64 * k];
    }
    for (int i = gtid; i < DEPTH * 2 * 16 * 64 * 16; i += NT) {
        const int kk = i & 15, p = (i >> 4) & 63, ldg = i >> 10, d = (ldg >> 4) & 1;
        const S5Lam L = s5_lam(c, ldg, p); float fre, fim, are, aim; s5_f(L, fre, fim); s5_pow(L, d == 0 ? 15 - kk : kk, are, aim);
        const float wre = are * fre - aim * fim, wim = are * fim + aim * fre;
        const float* br = c.in(I_BRE) + ((size_t)ldg * 64 + p) * 16; const float* bi = c.in(I_BIM) + ((size_t)ldg * 64 + p) * 16;
        unsigned ore[8], oim[8];
#pragma unroll
        for (int h = 0; h < 8; ++h) { const float b0r = br[2 * h], b0i = bi[2 * h], b1r = br[2 * h + 1], b1i = bi[2 * h + 1];
            ore[h] = pk2(wre * b0r - wim * b0i, wre * b1r - wim * b1i); oim[h] = pk2(wre * b0i + wim * b0r, wre * b1i + wim * b1r); }
        u32x4* pr = (u32x4*)(c.WE() + ((size_t)ldg * 128 + p) * 256 + kk * 16); u32x4* pi = (u32x4*)(c.WE() + ((size_t)ldg * 128 + 64 + p) * 256 + kk * 16);
        pr[0] = (u32x4){ore[0], ore[1], ore[2], ore[3]}; pr[1] = (u32x4){ore[4], ore[5], ore[6], ore[7]};
        pi[0] = (u32x4){oim[0], oim[1], oim[2], oim[3]}; pi[1] = (u32x4){oim[4], oim[5], oim[6], oim[7]};
    }
    for (int i = gtid; i < DEPTH * 2 * 16 * 16 * 64; i += NT) {
        const int p = i & 63, tt = (i >> 6) & 15, ldg = i >> 10, d = (ldg >> 4) & 1;
        const S5Lam L = s5_lam(c, ldg, p); float are, aim; s5_pow(L, d == 0 ? tt + 1 : 16 - tt, are, aim);
#pragma unroll 4
        for (int ho = 0; ho < 16; ++ho) { const float cr = c.in(I_CRE)[((size_t)ldg * 16 + ho) * 64 + p], ci = c.in(I_CIM)[((size_t)ldg * 16 + ho) * 64 + p];
            bf16_t* o = c.WC() + (((size_t)ldg * 16 + tt) * 16 + ho) * 128; o[p] = f2bf(cr * are - ci * aim); o[64 + p] = f2bf(-(cr * aim + ci * are)); }
    }
    for (int i4 = gtid; i4 < DEPTH * 16 * 31 * 16 * 4; i4 += NT) {
        const int pq = i4 & 3, i = i4 >> 2;
        const int ho = i & 15, di = (i >> 4) % 31, lg = (i >> 4) / 31, l = lg >> 4, g = lg & 15, delta = di - 15;
        float acc[16];
#pragma unroll
        for (int h = 0; h < 16; ++h) acc[h] = 0.f;
        for (int d = 0; d < 2; ++d) {
            if ((d == 0 && delta < 0) || (d == 1 && delta > 0)) continue;
            const int ldg = (l * 2 + d) * 16 + g, n = delta < 0 ? -delta : delta;
            for (int p = 16 * pq; p < 16 * pq + 16; ++p) {
                const S5Lam L = s5_lam(c, ldg, p); float fre, fim, are, aim; s5_f(L, fre, fim); s5_pow(L, n, are, aim);
                const float cr = c.in(I_CRE)[((size_t)ldg * 16 + ho) * 64 + p], ci = c.in(I_CIM)[((size_t)ldg * 16 + ho) * 64 + p];
                const float t_re = are * fre - aim * fim, t_im = are * fim + aim * fre;
                const float wre = cr * t_re - ci * t_im, wim = cr * t_im + ci * t_re;
                const float* br = c.in(I_BRE) + ((size_t)ldg * 64 + p) * 16; const float* bi = c.in(I_BIM) + ((size_t)ldg * 64 + p) * 16;
#pragma unroll
                for (int h = 0; h < 16; ++h) acc[h] += wre * br[h] - wim * bi[h];
            }
        }
#pragma unroll
        for (int h = 0; h < 16; ++h) { acc[h] += shx(acc[h], 1, c.lane); acc[h] += shx(acc[h], 2, c.lane); }
        if (delta == 0) { const float dsk = c.in(I_SD)[(l * 16 + g) * 16 + ho];
#pragma unroll
            for (int h = 0; h < 16; ++h) acc[h] += (h == ho) ? dsk : 0.f; }
        if (pq == 0) { u32x4* o = (u32x4*)(c.KC() + (((size_t)lg * 31 + di) * 16 + ho) * 16);
            o[0] = (u32x4){pk2(acc[0], acc[1]), pk2(acc[2], acc[3]), pk2(acc[4], acc[5]), pk2(acc[6], acc[7])};
            o[1] = (u32x4){pk2(acc[8], acc[9]), pk2(acc[10], acc[11]), pk2(acc[12], acc[13]), pk2(acc[14], acc[15])}; }
    }
    for (int i = gtid; i < DEPTH * 2 * 16 * 64; i += NT) {
        const S5Lam L = s5_lam(c, i >> 6, i & 63); float re, im; s5_pow(L, 16, re, im); c.A16()[i] = (f32x2){re, im}; s5_pow(L, 256, re, im); c.A256()[i] = (f32x2){re, im};
    }
}

__device__ __forceinline__ void norm_row_load(const Ctx& c, int row, int npend, f32x4 (&v)[4], bool from_input) {
    const int b = row / RPB, j = row - b * RPB;
    const f32x4* xr = (const f32x4*)((from_input && j >= CTX) ? c.in(I_X) + ((size_t)b * SEQ + (j - CTX)) * DM : c.X() + (size_t)row * DM) + c.lane;
#pragma unroll
    for (int k = 0; k < 4; ++k) v[k] = xr[64 * k];
    if (j < CTX && npend > 0) {
        for (int sp = 0; sp < npend; ++sp) { const u32x2* pr = (const u32x2*)((const bf16_t*)c.PART() + ((size_t)sp * 1024 + b * 256 + j) * DM) + c.lane;
#pragma unroll
            for (int k = 0; k < 4; ++k) { const u32x2 w = pr[64 * k]; v[k] += (f32x4){bf2f(w.x & 0xffff), bf2f(w.x >> 16), bf2f(w.y & 0xffff), bf2f(w.y >> 16)}; } }
        f32x4* xw = (f32x4*)(c.X() + (size_t)row * DM) + c.lane;
#pragma unroll
        for (int k = 0; k < 4; ++k) xw[64 * k] = v[k];
    }
}
__device__ __forceinline__ void norm_row_finish(const Ctx& c, int l, int sub, int row, const f32x4 (&v)[4], const float* gamma) {
    const int b = row / RPB, j = row - b * RPB, mi = (j < CTX) ? 4 : b;
    const float* sh = c.MODS() + ((size_t)l * 5 + mi) * (NMOD * DM) + (3 * sub) * DM; const float* sc = sh + DM;
    float s = 0.f;
#pragma unroll
    for (int k = 0; k < 4; ++k) s += (v[k].x * v[k].x + v[k].y * v[k].y) + (v[k].z * v[k].z + v[k].w * v[k].w);
    const float rstd = __builtin_amdgcn_rsqf(wave_sum(s, c.lane) * (1.f / DM) + EPS);
    u32x2* o = (u32x2*)(c.A() + (size_t)row * DM) + c.lane;
#pragma unroll
    for (int k = 0; k < 4; ++k) { const int col = (c.lane + 64 * k) * 4;
        const f32x4 g = *(const f32x4*)(gamma + col), scv = *(const f32x4*)(sc + col), shv = *(const f32x4*)(sh + col);
        const f32x4 y = v[k] * rstd * g * (scv + 1.f) + shv;
        o[64 * k] = (u32x2){pk2(y.x, y.y), pk2(y.z, y.w)}; }
}
__device__ __forceinline__ void phase_norm(const Ctx& c, int l, int sub, int npend) {
    const int gw = c.wave * c.G + c.bid, NGW = c.G * 8;
    const float* gamma = c.in(I_NSUB) + ((size_t)l * 3 + sub) * DM;
    if (c.G == 256) {
        const int x = c.bid & 7, xw = (c.bid >> 3) * 8 + c.wave;
        auto rowof = [&](int j) -> int { if (j < 2048) { const int L = (8 * x + (j >> 8)) * 256 + (j & 255); return (L >> 12) * RPB + CTX + (L & 4095); }
                                         const int cj = (j - 2048) + 128 * x; return (cj >> 8) * RPB + (cj & 255); };
        const bool hasc = xw < 128; const int nrow = hasc ? 9 : 8;
        for (int qi = 0; qi < nrow; qi += 2) {
            const bool two = qi + 1 < nrow;
            const int i0 = hasc ? (qi + 8) % 9 : qi, i1 = hasc ? (qi + 9) % 9 : qi + 1;
            const int j = xw + 256 * i0, j2 = xw + 256 * i1; const int row = rowof(j), row2 = rowof(two ? j2 : j);
            f32x4 v[4], w[4];
            norm_row_load(c, row, npend, v, l == 0 && sub == 0);
            if (two) norm_row_load(c, row2, npend, w, l == 0 && sub == 0);
            norm_row_finish(c, l, sub, row, v, gamma);
            if (two) norm_row_finish(c, l, sub, row2, w, gamma);
        }
        return;
    }
    for (int row = gw; row < MROWS; row += 2 * NGW) {
        const int row2 = row + NGW; const bool two = row2 < MROWS;
        f32x4 v[4], w[4];
        norm_row_load(c, row, npend, v, l == 0 && sub == 0);
        if (two) norm_row_load(c, row2, npend, w, l == 0 && sub == 0);
        norm_row_finish(c, l, sub, row, v, gamma);
        if (two) norm_row_finish(c, l, sub, row2, w, gamma);
    }
}
__device__ __forceinline__ void final_row(const Ctx& c, int r, const f32x4 (&v)[4]) {
    float s = 0.f;
#pragma unroll
    for (int k = 0; k < 4; ++k) s += (v[k].x * v[k].x + v[k].y * v[k].y) + (v[k].z * v[k].z + v[k].w * v[k].w);
    const float rstd = __builtin_amdgcn_rsqf(wave_sum(s, c.lane) * (1.f / DM) + EPS);
    f32x4* o = (f32x4*)(c.out() + (size_t)r * DM) + c.lane;
#pragma unroll
    for (int k = 0; k < 4; ++k) o[64 * k] = v[k] * rstd * *(const f32x4*)(c.in(I_FN) + (c.lane + 64 * k) * 4);
}
__device__ __forceinline__ void phase_final(const Ctx& c) {
    const int gw = c.wave * c.G + c.bid, NGW = c.G * 8;
    for (int r = gw; r < NB * SEQ; r += 2 * NGW) {
        const int r2 = r + NGW; const bool two = r2 < NB * SEQ; const int rb = two ? r2 : r;
        const f32x4* xa = (const f32x4*)(c.X() + ((size_t)(r / SEQ) * RPB + CTX + (r % SEQ)) * DM) + c.lane;
        const f32x4* xb = (const f32x4*)(c.X() + ((size_t)(rb / SEQ) * RPB + CTX + (rb % SEQ)) * DM) + c.lane;
        f32x4 v[4], w[4];
#pragma unroll
        for (int k = 0; k < 4; ++k) { v[k] = xa[64 * k]; w[k] = xb[64 * k]; }
        final_row(c, r, v);
        if (two) final_row(c, r2, w);
    }
}
__device__ __forceinline__ bf16x8 mk8(u32x2 a, u32x2 b) { u32x4 v = {a.x, a.y, b.x, b.y}; return __builtin_bit_cast(bf16x8, v); }
__device__ __forceinline__ f32x4 mfma16(bf16x8 a, bf16x8 b, f32x4 c) { return __builtin_amdgcn_mfma_f32_16x16x32_bf16(a, b, c, 0, 0, 0); }
__device__ __forceinline__ f32x16 mfma32(bf16x8 a, bf16x8 b, f32x16 c) { return __builtin_amdgcn_mfma_f32_32x32x16_bf16(a, b, c, 0, 0, 0); }

__device__ __forceinline__ void s5_states(const Ctx& c, int l, int item, LAS unsigned char* wl, int lane) {
    const int d = item & 1, g = (item >> 1) & 15, rbb = item >> 5, RB = rbb % NRB, b = rbb / NRB;
    const int G = lane & 15, q = lane >> 4;
    const size_t row0 = (size_t)b * RPB + 256 * RB;
    bf16x8 U[8];
#pragma unroll
    for (int ks = 0; ks < 8; ++ks) U[ks] = *(const bf16x8*)(c.P() + (row0 + 16 * G + 2 * ks + (q >> 1)) * INW + 1024 + g * 16 + 8 * (q & 1));
    LAS float* Eb = (LAS float*)wl;
    const int ldg = (l * 2 + d) * 16 + g;
    const bf16_t* we = c.WE() + (size_t)ldg * 128 * 256 + (size_t)G * 256 + 8 * q;
    f32x4 acc[8];
#pragma unroll
    for (int rbE = 0; rbE < 8; ++rbE) acc[rbE] = (f32x4){0.f, 0.f, 0.f, 0.f};
#pragma unroll
    for (int ks = 0; ks < 8; ++ks)
#pragma unroll
        for (int rbE = 0; rbE < 8; ++rbE) acc[rbE] = mfma16(*(const bf16x8*)(we + (size_t)rbE * 16 * 256 + 32 * ks), U[ks], acc[rbE]);
#pragma unroll
    for (int rbE = 0; rbE < 8; ++rbE) *(LAS f32x4*)(Eb + G * 132 + 16 * rbE + 4 * q) = acc[rbE];
    LDS_WAIT();
    const f32x2 a16 = c.A16()[ldg * 64 + lane];
    float sre = 0.f, sim = 0.f;
    const size_t bdg = (size_t)((b * 2 + d) * 16 + g) * NRB + RB;
    bf16_t* spl = c.SPL() + bdg * 16 * 128;
#pragma unroll
    for (int i = 0; i < 16; ++i) { const int Gs = (d == 0) ? i : 15 - i;
        spl[Gs * 128 + lane] = f2bf(sre); spl[Gs * 128 + 64 + lane] = f2bf(sim);
        const float er = Eb[Gs * 132 + lane], ei = Eb[Gs * 132 + 64 + lane];
        const float nr = a16.x * sre - a16.y * sim + er, ni = a16.x * sim + a16.y * sre + ei; sre = nr; sim = ni; }
    float* o = c.EB() + bdg * 128; o[lane] = sre; o[64 + lane] = sim;
    LDS_WAIT();
}
__device__ __forceinline__ void s5_outputs(const Ctx& c, int l, int item, LAS unsigned char* wl, int lane) {
    const int half = item & 1, g = (item >> 1) & 15, rbb = item >> 5, RB = rbb % NRB, b = rbb / NRB;
    const int G = lane & 15, q = lane >> 4;
    const size_t row0 = (size_t)b * RPB + 256 * RB;
    bf16x8 U[8];
#pragma unroll
    for (int ks = 0; ks < 8; ++ks) U[ks] = *(const bf16x8*)(c.P() + (row0 + 16 * G + 2 * ks + (q >> 1)) * INW + 1024 + g * 16 + 8 * (q & 1));
    LAS bf16_t* SP = (LAS bf16_t*)wl;
#pragma unroll
    for (int d = 0; d < 2; ++d) {
        const int ldg = (l * 2 + d) * 16 + g;
        const f32x2 a16 = c.A16()[ldg * 64 + lane], a256 = c.A256()[ldg * 64 + lane];
        const size_t bdg0 = (size_t)((b * 2 + d) * 16 + g) * NRB;
        const float* eb = c.EB() + bdg0 * 128;
        float pre = 0.f, pim = 0.f;
        const int npre = (d == 0) ? RB : (RB == 0 ? 0 : NRB - RB);
        for (int i = 0; i < npre; ++i) { const int rp = (d == 0) ? i : (i == 0 ? 0 : NRB - i);
            const float er = eb[rp * 128 + lane], ei = eb[rp * 128 + 64 + lane];
            const float nr = a256.x * pre - a256.y * pim + er, ni = a256.x * pim + a256.y * pre + ei; pre = nr; pim = ni; }
        const bf16_t* spl = c.SPL() + (bdg0 + RB) * 16 * 128;
        float lr[16], li[16];
#pragma unroll
        for (int i = 0; i < 16; ++i) { lr[i] = bf2f(spl[i * 128 + lane]); li[i] = bf2f(spl[i * 128 + 64 + lane]); }
#pragma unroll
        for (int i = 0; i < 16; ++i) { const int Gs = (d == 0) ? i : 15 - i;
            SP[(d * 16 + Gs) * 136 + lane] = f2bf(lr[Gs] + pre); SP[(d * 16 + Gs) * 136 + 64 + lane] = f2bf(li[Gs] + pim);
            const float nr = a16.x * pre - a16.y * pim, ni = a16.x * pim + a16.y * pre; pre = nr; pim = ni; }
    }
    LDS_WAIT();
    const float* gw = c.in(I_GW) + ((size_t)(l * 16 + g) * 16 + 4 * q) * 16;
    f32x4 Wg[4][4];
#pragma unroll
    for (int jj = 0; jj < 4; ++jj)
#pragma unroll
        for (int k4 = 0; k4 < 4; ++k4) Wg[jj][k4] = *(const f32x4*)(gw + jj * 16 + 4 * k4);
    const f32x4 bias = *(const f32x4*)(c.in(I_GB) + (l * 16 + g) * 16 + 4 * q);
    const bf16_t* kc = c.KC() + (size_t)(l * 16 + g) * 31 * 256 + G * 16 + 8 * (q & 1);
    const bool b0 = (q & 1) != 0, b1 = (q & 2) != 0;
#pragma unroll 2
    for (int t8 = 0; t8 < 8; ++t8) { const int tt = half * 8 + t8;
        f32x4 acc = {0.f, 0.f, 0.f, 0.f};
#pragma unroll
        for (int ks = 0; ks < 8; ++ks) acc = mfma16(*(const bf16x8*)(kc + (tt - (2 * ks + (q >> 1)) + 15) * 256), U[ks], acc);
        f32x4 acc2 = {0.f, 0.f, 0.f, 0.f};
#pragma unroll
        for (int d = 0; d < 2; ++d) {
            const bf16_t* wc = c.WC() + ((((size_t)(l * 2 + d) * 16 + g) * 16 + tt) * 16 + G) * 128 + 8 * q;
#pragma unroll
            for (int ks = 0; ks < 4; ++ks) acc2 = mfma16(*(const bf16x8*)(wc + 32 * ks), *(const LAS bf16x8*)(SP + (d * 16 + G) * 136 + 32 * ks + 8 * q), acc2); }
        acc += acc2;
        float gv[4];
#pragma unroll
        for (int j = 0; j < 4; ++j) { const float x = acc[j]; gv[j] = x * sigmoidf_(1.5957691216057308f * (x + 0.044715f * x * x * x)); }
        f32x4 pz[4];
#pragma unroll
        for (int k4 = 0; k4 < 4; ++k4) pz[k4] = Wg[0][k4] * gv[0] + Wg[1][k4] * gv[1] + Wg[2][k4] * gv[2] + Wg[3][k4] * gv[3];
        f32x4 r8[2];
#pragma unroll
        for (int h2 = 0; h2 < 2; ++h2) { const f32x4 keep = b1 ? pz[2 + h2] : pz[h2], send = b1 ? pz[h2] : pz[2 + h2]; f32x4 rc;
#pragma unroll
            for (int e = 0; e < 4; ++e) rc[e] = shx(send[e], 32, lane);
            r8[h2] = keep + rc; }
        const f32x4 keep = b0 ? r8[1] : r8[0], send = b0 ? r8[0] : r8[1]; f32x4 z;
#pragma unroll
        for (int e = 0; e < 4; ++e) z[e] = keep[e] + shx(send[e], 16, lane);
        f32x4 o;
#pragma unroll
        for (int j = 0; j < 4; ++j) o[j] = gv[j] * sigmoidf_(z[j] + bias[j]);
        *(f32x4*)(c.SSMO() + (row0 + 16 * G + tt) * 256 + g * 16 + 4 * q) = o;
    }
    LDS_WAIT();
}

__device__ __forceinline__ void phase_p1(const Ctx& c, int l) {
    LAS bf16_t* ub = (LAS bf16_t*)c.lds;
    LAS bf16_t* pooled = (LAS bf16_t*)(c.lds + 40960);
    LAS bf16_t* vt = (LAS bf16_t*)(c.lds + 40960 + 33792);
    for (int k_ = 0; ; ++k_) {
        int item;
        if (c.G == 256) { if (k_ == 0) item = c.bid; else if (k_ == 1 && c.bid >= 128 && c.bid < 144) item = 128 + c.bid; else break; }
        else { item = c.bid + k_ * c.G; if (item >= MROWS / 64) break; }
        const int row0 = item * 64, b = row0 / RPB, j0 = row0 - b * RPB;
        const bool lat = j0 >= CTX; const int seg0 = lat ? CTX : 0, segL = lat ? SEQ : CTX, t0 = j0 - seg0;
        for (int i = c.tid; i < 80 * 32; i += 512) { const int r = i >> 5, ch = i & 31, t = t0 - 8 + r;
            u32x4 v = {0u, 0u, 0u, 0u};
            if (t >= 0 && t < segL) v = *(const u32x4*)(c.P() + ((size_t)b * RPB + seg0 + t) * INW + 768 + 8 * ch);
            *(LAS u32x4*)(ub + r * 256 + 8 * ch) = v; }
        for (int i = c.tid; i < 1024; i += 512) { const int r = i >> 4, kv = (i >> 3) & 1, ch = i & 7;
            *(LAS u32x4*)(vt + (kv * 64 + r) * 64 + 8 * ch) = *(const u32x4*)(c.P() + (size_t)(row0 + r) * INW + 640 + kv * 64 + 8 * ch); }
        __syncthreads();
        for (int i = c.tid; i < 1024; i += 512) { const int kv = i >> 9, d = (i >> 3) & 63, ch = i & 7;
            unsigned short e[8];
#pragma unroll
            for (int k = 0; k < 8; ++k) e[k] = vt[(kv * 64 + 8 * ch + k) * 64 + d];
            u32x4 w = {(unsigned)e[0] | ((unsigned)e[1] << 16), (unsigned)e[2] | ((unsigned)e[3] << 16), (unsigned)e[4] | ((unsigned)e[5] << 16), (unsigned)e[6] | ((unsigned)e[7] << 16)};
            *(u32x4*)(c.Vt() + ((size_t)(b * 2 + kv) * 64 + d) * RPB + j0 + 8 * ch) = w; }
        { const int ch = c.tid & 255, th = c.tid >> 8, w = 2 << (ch >> 6), hw = w >> 1;
            const int tl0 = th * 32; float s = 0.f;
            for (int r = tl0 + 8 - hw; r < tl0 + 8 + hw; ++r) s += bf2f(ub[r * 256 + ch]);
#pragma unroll 4
            for (int tl = tl0; tl < tl0 + 32; ++tl) { const int t = t0 + tl;
                const int lo = max(t - hw, 0), hi = min(t + hw, segL);
                pooled[tl * 264 + ch] = f2bf(s * fast_rcp((float)(hi - lo)) - bf2f(ub[(tl + 8) * 256 + ch]));
                s += bf2f(ub[(tl + 8 + hw) * 256 + ch]) - bf2f(ub[(tl + 8 - hw) * 256 + ch]); } }
        __syncthreads();
        { const int g = c.wave >> 1, th = c.wave & 1, G16 = c.lane & 15, q = c.lane >> 4;
            const float* pw = c.in(I_PW) + ((size_t)(l * 4 + g) * 64) * 64 + G16;
            bf16x8 Bf[4][2]; float ps[4];
#pragma unroll
            for (int db = 0; db < 4; ++db) { ps[db] = c.in(I_PS)[l * 256 + g * 64 + 16 * db + G16];
#pragma unroll
                for (int ks = 0; ks < 2; ++ks) { float w8[8];
#pragma unroll
                    for (int j = 0; j < 8; ++j) w8[j] = pw[(size_t)(32 * ks + 8 * q + j) * 64 + 16 * db];
                    u32x4 w = {pk2(w8[0], w8[1]), pk2(w8[2], w8[3]), pk2(w8[4], w8[5]), pk2(w8[6], w8[7])}; Bf[db][ks] = __builtin_bit_cast(bf16x8, w); } }
#pragma unroll
            for (int rb = 0; rb < 2; ++rb) {
                const LAS bf16_t* ap = pooled + (32 * th + 16 * rb + G16) * 264 + g * 64 + 8 * q;
                const bf16x8 A0 = *(const LAS bf16x8*)ap, A1 = *(const LAS bf16x8*)(ap + 32);
                bf16_t* orow = c.A() + (size_t)(row0 + 32 * th + 16 * rb + 4 * q) * DM + 512 + g * 64 + G16;
#pragma unroll
                for (int db = 0; db < 4; ++db) { f32x4 acc = {0.f, 0.f, 0.f, 0.f};
                    acc = mfma16(A0, Bf[db][0], acc); acc = mfma16(A1, Bf[db][1], acc);
#pragma unroll
                    for (int j = 0; j < 4; ++j) orow[(size_t)j * DM + 16 * db] = f2bf(acc[j] * ps[db]); } } }
        __syncthreads();
    }
    const int gw = c.wave * c.G + c.bid, NGW = c.G * 8;
    { const int cq = c.lane & 7, h8 = c.lane >> 3, axis = cq >> 2, half = (cq >> 1) & 1;
        float qg[8], kg[8], inv[8];
#pragma unroll
        for (int i = 0; i < 8; ++i) { qg[i] = c.in(I_QN)[l * 64 + 8 * cq + i] * C2; kg[i] = c.in(I_KN)[l * 64 + 8 * cq + i];
            inv[i] = exp2f(-(float)(8 * (cq & 1) + i) * (13.287712379549449f / 16.f)) * 0.15915494309189535f; }
#define QK_PASS(RAW, ROW, GAM, OUT) do { \
            float v_[8]; v_[0] = bf2f(RAW.x & 0xffff); v_[1] = bf2f(RAW.x >> 16); v_[2] = bf2f(RAW.y & 0xffff); v_[3] = bf2f(RAW.y >> 16); \
            v_[4] = bf2f(RAW.z & 0xffff); v_[5] = bf2f(RAW.z >> 16); v_[6] = bf2f(RAW.w & 0xffff); v_[7] = bf2f(RAW.w >> 16); \
            float ss_ = 0.f; _Pragma("unroll") for (int i = 0; i < 8; ++i) ss_ += v_[i] * v_[i]; \
            ss_ += shx(ss_, 1, c.lane); ss_ += shx(ss_, 2, c.lane); ss_ += shx(ss_, 4, c.lane); \
            const float rs_ = __builtin_amdgcn_rsqf(ss_ * (1.f / 64.f) + EPS); \
            const int j_ = (ROW) % RPB; const bool lat_ = j_ >= CTX; const int t_ = j_ - CTX; const float pos_ = (float)(axis == 0 ? (t_ >> 6) : (t_ & 63)); \
            float y_[8]; _Pragma("unroll") for (int i = 0; i < 8; ++i) y_[i] = v_[i] * rs_ * GAM[i]; \
            _Pragma("unroll") for (int i = 0; i < 8; ++i) { const float ot_ = shx(y_[i], 2, c.lane); float fr_ = pos_ * inv[i]; fr_ -= __builtin_rintf(fr_); \
                const float cs_ = lat_ ? __builtin_amdgcn_cosf(fr_) : 1.f, sn_ = lat_ ? __builtin_amdgcn_sinf(fr_) : 0.f; \
                y_[i] = half == 0 ? y_[i] * cs_ - ot_ * sn_ : y_[i] * cs_ + ot_ * sn_; } \
            OUT = (u32x4){pk2(y_[0], y_[1]), pk2(y_[2], y_[3]), pk2(y_[4], y_[5]), pk2(y_[6], y_[7])}; } while (0)
        for (int r0 = gw; r0 < MROWS; r0 += 4 * NGW) {
            u32x4 rq[4], rk; int rows[4];
#pragma unroll
            for (int i = 0; i < 4; ++i) { rows[i] = (r0 + i * NGW < MROWS) ? r0 + i * NGW : r0; rq[i] = *(const u32x4*)(c.P() + (size_t)rows[i] * INW + h8 * 64 + 8 * cq); }
            const int krow = (r0 + (c.lane >> 4) * NGW < MROWS) ? r0 + (c.lane >> 4) * NGW : r0, kh = h8 & 1;
            rk = *(const u32x4*)(c.P() + (size_t)krow * INW + 512 + kh * 64 + 8 * cq);
#pragma unroll
            for (int i = 0; i < 4; ++i) { u32x4 o; QK_PASS(rq[i], rows[i], qg, o);
                if (i == 0 || r0 + i * NGW < MROWS) *(u32x4*)(c.Q() + (size_t)rows[i] * 512 + h8 * 64 + 8 * cq) = o; }
            { u32x4 o; QK_PASS(rk, krow, kg, o);
                if ((c.lane >> 4) == 0 || r0 + (c.lane >> 4) * NGW < MROWS) { const int b = krow / RPB, j = krow - b * RPB;
                    *(u32x4*)(c.Kb() + ((size_t)(b * 2 + kh) * RPB + j) * 64 + 8 * cq) = o; } }
        }
#undef QK_PASS
    }
    for (int it = gw; it < NB * NRB * 32; it += NGW) s5_states(c, l, it, c.lds + c.wave * 8704, c.lane);
}

__device__ __forceinline__ void attn_unit(const Ctx& c, int u) {
    int b, kvh, qb;
    if (u < 256) { b = u >> 6; kvh = (u >> 5) & 1; qb = 2 + (u & 31); } else { const int v = u - 256; b = v >> 2; kvh = (v >> 1) & 1; qb = v & 1; }
    const int nt = (qb < 2) ? CTX / 64 : RPB / 64;
    const int wid = c.wave, lane = c.lane, tid = c.tid;
    const int hq = kvh * 4 + (wid >> 1), j0 = 128 * qb + 64 * (wid & 1), qc = lane & 31, hi = lane >> 5;
    LAS unsigned char* L = c.lds;
    bf16x8 qf[2][4];
#pragma unroll
    for (int qk = 0; qk < 2; ++qk)
#pragma unroll
        for (int ds = 0; ds < 4; ++ds) qf[qk][ds] = *(const bf16x8*)(c.Q() + ((size_t)b * RPB + j0 + 32 * qk + qc) * 512 + hq * 64 + 16 * ds + 8 * hi);
    const int sr = tid >> 3, sc = tid & 7;
    const bf16_t* Kg = c.Kb() + (size_t)(b * 2 + kvh) * RPB * 64;
    const bf16_t* Vg = c.Vt() + (size_t)(b * 2 + kvh) * 64 * RPB;
    const int koff = sr * 64 + sc * 8, voff = sr * RPB + sc * 8;
    const int soff = (sr * 72 + sc * 8) * 2;
    u32x4 kreg = *(const u32x4*)(Kg + koff), vreg = *(const u32x4*)(Vg + voff);
    const int vsoff = (sr * 72 + 16 * (sc >> 1) + 4 * (sc & 1)) * 2;
    *(LAS u32x4*)(L + soff) = kreg; *(LAS u32x2*)(L + 18432 + vsoff) = (u32x2){vreg.x, vreg.y}; *(LAS u32x2*)(L + 18432 + vsoff + 16) = (u32x2){vreg.z, vreg.w};
    __syncthreads();
    f32x16 O[2][2];
#pragma unroll
    for (int a = 0; a < 2; ++a)
#pragma unroll
        for (int bb = 0; bb < 2; ++bb)
#pragma unroll
            for (int r = 0; r < 16; ++r) O[a][bb][r] = 0.f;
    float mref[2] = {0.f, 0.f}, lsum[2] = {0.f, 0.f};
    bool shifted = false;
#pragma unroll 1
    for (int t = 0; t < nt; ++t) {
        const int cur = t & 1;
        if (t + 1 < nt) { kreg = *(const u32x4*)(Kg + (size_t)(t + 1) * 4096 + koff); vreg = *(const u32x4*)(Vg + (size_t)(t + 1) * 64 + voff); }
        const LAS unsigned char* Kt = L + cur * 9216; const LAS unsigned char* Vt = L + 18432 + cur * 9216;
        f32x16 S[2][2];
#pragma unroll
        for (int kb = 0; kb < 2; ++kb)
#pragma unroll
            for (int ds = 0; ds < 4; ++ds) { const bf16x8 kf = *(const LAS bf16x8*)(Kt + ((32 * kb + qc) * 72 + 16 * ds + 8 * hi) * 2);
#pragma unroll
                for (int qk = 0; qk < 2; ++qk) {
                    if (ds == 0) { f32x16 z;
#pragma unroll
                        for (int r = 0; r < 16; ++r) z[r] = 0.f;
                        S[kb][qk] = mfma32(kf, qf[qk][ds], z); }
                    else S[kb][qk] = mfma32(kf, qf[qk][ds], S[kb][qk]); } }
        if (shifted) {
#pragma unroll
            for (int qk = 0; qk < 2; ++qk)
#pragma unroll
                for (int r = 0; r < 16; ++r) { S[0][qk][r] -= mref[qk]; S[1][qk][r] -= mref[qk]; }
        }
        float mt[2];
#pragma unroll
        for (int qk = 0; qk < 2; ++qk) { float m0 = fmaxf(S[0][qk][0], S[1][qk][0]);
#pragma unroll
            for (int r = 1; r < 16; ++r) m0 = fmaxf(fmaxf(m0, S[0][qk][r]), S[1][qk][r]);
            mt[qk] = m0; }
        if (__builtin_amdgcn_ballot_w64(fmaxf(mt[0], mt[1]) > 8.f) != 0ull) {
#pragma unroll
            for (int qk = 0; qk < 2; ++qk) { const float mo = fmaxf(mt[qk], shx(mt[qk], 32, lane)), up = fmaxf(mo, 0.f), alpha = fast_exp2(-up);
                mref[qk] += up; lsum[qk] *= alpha;
#pragma unroll
                for (int r = 0; r < 16; ++r) { S[0][qk][r] -= up; S[1][qk][r] -= up; O[0][qk][r] *= alpha; O[1][qk][r] *= alpha; } }
            shifted = true;
        }
#pragma unroll
        for (int qk = 0; qk < 2; ++qk) { float ps = 0.f;
#pragma unroll
            for (int kb = 0; kb < 2; ++kb)
#pragma unroll
                for (int r = 0; r < 16; ++r) { const float p = fast_exp2(S[kb][qk][r]); S[kb][qk][r] = p; ps += p; }
            lsum[qk] += ps; }
#pragma unroll
        for (int kb = 0; kb < 2; ++kb)
#pragma unroll
            for (int s2 = 0; s2 < 2; ++s2) { const int s = 2 * kb + s2;
                bf16x8 pb[2];
#pragma unroll
                for (int qk = 0; qk < 2; ++qk) { u32x4 w = {pk2(S[kb][qk][8 * s2 + 0], S[kb][qk][8 * s2 + 1]), pk2(S[kb][qk][8 * s2 + 2], S[kb][qk][8 * s2 + 3]),
                                                           pk2(S[kb][qk][8 * s2 + 4], S[kb][qk][8 * s2 + 5]), pk2(S[kb][qk][8 * s2 + 6], S[kb][qk][8 * s2 + 7])};
                    pb[qk] = __builtin_bit_cast(bf16x8, w); }
#pragma unroll
                for (int db = 0; db < 2; ++db) {
                    const bf16x8 vf = *(const LAS bf16x8*)(Vt + ((32 * db + qc) * 72 + 16 * s + 8 * hi) * 2);
#pragma unroll
                    for (int qk = 0; qk < 2; ++qk) O[db][qk] = mfma32(vf, pb[qk], O[db][qk]); } }
        if (t + 1 < nt) { *(LAS u32x4*)(L + (cur ^ 1) * 9216 + soff) = kreg; *(LAS u32x2*)(L + 18432 + (cur ^ 1) * 9216 + vsoff) = (u32x2){vreg.x, vreg.y}; *(LAS u32x2*)(L + 18432 + (cur ^ 1) * 9216 + vsoff + 16) = (u32x2){vreg.z, vreg.w}; }
        __syncthreads();
    }
    int qc2 = qc, hi2 = hi; asm volatile("" : "+v"(qc2), "+v"(hi2));
#pragma unroll
    for (int qk = 0; qk < 2; ++qk) {
        const float inv = 1.f / (lsum[qk] + shx(lsum[qk], 32, lane));
        bf16_t* orow = c.O() + ((size_t)b * RPB + j0 + 32 * qk + qc2) * 512 + hq * 64 + 4 * hi2;
#pragma unroll
        for (int db = 0; db < 2; ++db)
#pragma unroll
            for (int rg = 0; rg < 4; ++rg)
                *(u32x2*)(orow + 32 * db + 8 * rg) = (u32x2){pk2(O[db][qk][4 * rg] * inv, O[db][qk][4 * rg + 1] * inv), pk2(O[db][qk][4 * rg + 2] * inv, O[db][qk][4 * rg + 3] * inv)};
    }
}
__device__ __forceinline__ void phase_p2(const Ctx& c, int l) {
    { const int gw = c.wave * c.G + c.bid, NGW = c.G * 8;
        if (l == DEPTH - 1) {
            for (int k = gw; k < NB * (NRB - 1) * 32; k += NGW) { const int rb2 = k >> 5, b = rb2 / (NRB - 1), RB = 1 + rb2 % (NRB - 1);
                s5_outputs(c, l, ((b * NRB + RB) << 5) | (k & 31), c.lds + c.wave * 8704, c.lane); }
        } else
        for (int it = gw; it < NB * NRB * 32; it += NGW) s5_outputs(c, l, it, c.lds + c.wave * 8704, c.lane); }
    __syncthreads();
    for (int k_ = 0; ; ++k_) {
        int u;
        if (c.G == 256) { if (k_ == 0) u = (c.bid & 7) * 32 + (c.bid >> 3); else if (k_ == 1 && c.bid >= 128 && c.bid < 144) u = 128 + c.bid; else break; }
        else { u = c.bid + k_ * c.G; if (u >= 272) break; }
        if (u >= 256 && l == DEPTH - 1) break;
        attn_unit(c, u);
    }
}
__device__ __forceinline__ void p3_finish(const Ctx& c, int row, const u32x4 ov, const f32x4 sv, const float* ga, const float* gs) {
    float o[8]; o[0] = bf2f(ov.x & 0xffff); o[1] = bf2f(ov.x >> 16); o[2] = bf2f(ov.y & 0xffff); o[3] = bf2f(ov.y >> 16); o[4] = bf2f(ov.z & 0xffff); o[5] = bf2f(ov.z >> 16); o[6] = bf2f(ov.w & 0xffff); o[7] = bf2f(ov.w >> 16);
    float s = 0.f;
#pragma unroll
    for (int k = 0; k < 8; ++k) s += o[k] * o[k];
    float s2 = sv.x * sv.x + sv.y * sv.y + sv.z * sv.z + sv.w * sv.w;
#pragma unroll
    for (int m = 1; m < 64; m <<= 1) { s += shx(s, m, c.lane); s2 += shx(s2, m, c.lane); }
    const float ra = __builtin_amdgcn_rsqf(s * (1.f / 512.f) + EPS), rs = __builtin_amdgcn_rsqf(s2 * (1.f / 256.f) + EPS);
    const f32x4 g0 = *(const f32x4*)(ga + 8 * c.lane), g1 = *(const f32x4*)(ga + 8 * c.lane + 4);
    *((u32x4*)(c.A() + (size_t)row * DM) + c.lane) = (u32x4){pk2(o[0] * ra * g0.x, o[1] * ra * g0.y), pk2(o[2] * ra * g0.z, o[3] * ra * g0.w), pk2(o[4] * ra * g1.x, o[5] * ra * g1.y), pk2(o[6] * ra * g1.z, o[7] * ra * g1.w)};
    const f32x4 g2 = *(const f32x4*)(gs + 4 * c.lane);
    *((u32x2*)(c.A() + (size_t)row * DM + 768) + c.lane) = (u32x2){pk2(sv.x * rs * g2.x, sv.y * rs * g2.y), pk2(sv.z * rs * g2.z, sv.w * rs * g2.w)};
}
__device__ __forceinline__ void phase_p3(const Ctx& c, int l) {
    const int gw = c.wave * c.G + c.bid, NGW = c.G * 8;
    const float* ga = c.in(I_AON) + l * 512; const float* gs = c.in(I_SON) + l * 256;
    for (int row = gw; row < MROWS; row += 2 * NGW) {
        const int row2 = row + NGW; const bool two = row2 < MROWS; const int r2 = two ? row2 : row;
        const u32x4 ov = *((const u32x4*)(c.O() + (size_t)row * 512) + c.lane); const f32x4 sv = *((const f32x4*)(c.SSMO() + (size_t)row * 256) + c.lane);
        const u32x4 ov2 = *((const u32x4*)(c.O() + (size_t)r2 * 512) + c.lane); const f32x4 sv2 = *((const f32x4*)(c.SSMO() + (size_t)r2 * 256) + c.lane);
        p3_finish(c, row, ov, sv, ga, gs);
        if (two) p3_finish(c, row2, ov2, sv2, ga, gs);
    }
}
__global__ void __launch_bounds__(512, 2) fwd_megakernel(Params p) {
    extern __shared__ __attribute__((aligned(16))) unsigned char lds[];
    cg::grid_group grid = cg::this_grid();
    Ctx c; c.p = &p;
    c.lds = (LAS unsigned char*)lds;
    const int wave_s = __builtin_amdgcn_readfirstlane((int)threadIdx.x >> 6);
#define REFRESH() do { int w_ = wave_s, b_ = blockIdx.x; asm volatile("" : "+s"(w_), "+s"(b_)); c.wave = w_; c.bid = b_; c.lane = hw_lane(); c.tid = w_ * 64 + c.lane; } while (0)
    c.G = gridDim.x; REFRESH();
    if (c.tid < 2) ((LAS unsigned*)(c.lds + LDS_ST_OFF))[c.tid] = 0u;
    __syncthreads();
    (void)xcd_barrier_post((unsigned*)(p.ws + WS_BAR), (volatile LAS unsigned*)(c.lds + LDS_ST_OFF), c.tid);
#define GSYNC() do { XcdBarrier xb_; xb_.bar = (unsigned*)(p.ws + WS_BAR); xb_.x = xb_xcc_id(); xb_.st = (volatile LAS unsigned*)(c.lds + LDS_ST_OFF); xcd_barrier(xb_, c.tid); REFRESH(); } while (0)

    phase_prep(c);
    if (p.ws == nullptr) grid.sync();
    GSYNC();
#pragma unroll 1
    for (int l = 0; l < DEPTH; ++l) {
        const float* modl = c.MODS() + (size_t)l * 5 * (NMOD * DM);
#pragma unroll 1
        for (int sub = 0; sub < 3; ++sub) {
            REFRESH();
            phase_norm(c, l, sub, ((l == 0 && sub == 0) || (l == DEPTH - 1 && sub == 2)) ? 0 : (sub == 2 ? 4 : 11));
            GSYNC();
            if (sub != 1) {
                const int f = sub >> 1;
                pg8::Gemm g{c.A(), c.WGU() + (size_t)(l * 2 + f) * 5632 * 1024, MROWS, 5632, 1024, 16}; pg8::StaticOrder S; S.init(MROWS, 5632, c.G, c.bid);
                EpiSwiGLU E{c.H()};
                pg8::gemm_phase<EpiSwiGLU, pg8::StaticOrder, true, true>(c.lds, g, S, E, c.tid);
            } else {
                { pg8::Gemm g{c.A(), c.WIN() + (size_t)l * INW * 1024, MROWS, INW, 1024, 16}; pg8::StaticOrder S; S.init(MROWS, INW, c.G, c.bid);
                  EpiP E{c.P()};
                  pg8::gemm_phase<EpiP, pg8::StaticOrder, true, true>(c.lds, g, S, E, c.tid); }
                if (l + 1 < DEPTH) {
                    REFRESH();
                    LAS float* scr = (LAS float*)(c.lds + c.wave * 8704);
                    if (c.G == 256) { if (c.bid >= 84) for (int it = (c.bid - 84) * 8 + c.wave; it < TR_PER_LAYER; it += 172 * 8) transpose_layer_item(c, l + 1, it, scr); }
                    else for (int it = c.wave * c.G + c.bid; it < TR_PER_LAYER; it += c.G * 8) transpose_layer_item(c, l + 1, it, scr);
                }
                GSYNC();
                phase_p1(c, l);
                GSYNC();
                phase_p2(c, l);
                GSYNC();
                phase_p3(c, l);
            }
            GSYNC();
            {
                const bool ffn = sub != 1; const int f = sub >> 1;
                const int K = ffn ? DFF : 1024;
                const bf16_t* Ap = ffn ? c.H() : c.A(); const bf16_t* Bp = ffn ? c.WD() + (size_t)(l * 2 + f) * 1024 * DFF : c.WOUT() + (size_t)l * 1024 * 1024;
                pg8::Gemm g{Ap, Bp, MROWS, 1024, K, K / 64}; ResidOrder S; S.init(K, c.G, c.bid, l == DEPTH - 1 && sub >= 1);
                EpiResidBoth E{c.X(), c.PART(), modl, (3 * sub + 2) * DM, ffn ? 0.5f : 1.0f, (l == 0 && sub == 0) ? c.in(I_X) : nullptr};
                pg8::gemm_phase<EpiResidBoth, ResidOrder, true, true>(c.lds, g, S, E, c.tid);
            }
            GSYNC();
        }
    }
    phase_final(c);
}

extern "C" void kernel_launch(void* const* d_in, const int* in_sizes, int n_in, void* d_out, int out_size, void* d_ws, size_t ws_size, hipStream_t stream) {
    static int grid_blocks = 0;
    if (grid_blocks == 0) {
        if (n_in != 29 || ws_size < WS_END) { fprintf(stderr, "kernel_launch: unexpected n_in %d or ws_size %zu (< %zu)\n", n_in, ws_size, (size_t)WS_END); grid_blocks = -1; return; }
        int dev = 0, cus = 0, per_cu = 0;
        hipGetDevice(&dev);
        hipDeviceGetAttribute(&cus, hipDeviceAttributeMultiprocessorCount, dev);
        hipFuncSetAttribute((const void*)fwd_megakernel, hipFuncAttributeMaxDynamicSharedMemorySize, LDS_BYTES);
        hipOccupancyMaxActiveBlocksPerMultiprocessor(&per_cu, (const void*)fwd_megakernel, 512, LDS_BYTES);
        if (per_cu < 1) per_cu = 1;
        grid_blocks = cus * per_cu;
        fprintf(stderr, "kernel_launch: grid %d (cus %d x %d)\n", grid_blocks, cus, per_cu);
    }
    if (grid_blocks < 0) return;
    (void)hipMemsetAsync((unsigned char*)d_ws + WS_BAR, 0, 16384, stream);
    Params p{};
    for (int i = 0; i < 29; ++i) p.in[i] = (const float*)d_in[i];
    p.out = (float*)d_out; p.ws = (unsigned char*)d_ws;
    void* args[] = {&p};
    hipError_t e = hipLaunchCooperativeKernel((const void*)fwd_megakernel, dim3(grid_blocks), dim3(512), args, LDS_BYTES, stream);
    if (e != hipSuccess) fprintf(stderr, "cooperative launch failed: %s (grid %d)\n", hipGetErrorString(e), grid_blocks);
}
```

```cpp
#include <hip/hip_runtime.h>
#include <hip/hip_cooperative_groups.h>
#include <cstdio>
#include <cstdint>
namespace cg = cooperative_groups;
namespace pg8 {
#define PG8_LAS __attribute__((address_space(3)))
typedef unsigned short bf16_t;
typedef short bf16x8 __attribute__((ext_vector_type(8)));
typedef float f32x4 __attribute__((ext_vector_type(4)));
typedef unsigned u32x4 __attribute__((ext_vector_type(4)));
constexpr int BM = 256, BK = 64, HALF = 128, HTB = HALF * BK * 2  , STAGE_BYTES = 8 * HTB, NXCD = 8, WGM = 8;

__host__ __device__ __forceinline__ int lds_byte(int r, int c) { const int st = (r >> 4) * 2 + (c >> 5), rr = r & 15, cc = c & 31, ob = rr * 64 + cc * 2; return st * 1024 + (ob ^ (((ob >> 9) & 1) << 5)); }
__host__ __device__ __forceinline__ void stage_rc(int b, int& R, int& C) { const int st = b / 1024, sb = b % 1024, swz = sb ^ (((sb >> 9) & 1) << 5); R = (st >> 1) * 16 + swz / 64; C = (st & 1) * 32 + (swz % 64) / 2; }
__host__ __device__ __forceinline__ int perm32(int rho) { const int n = rho >> 4, i = rho & 15; return 8 * (i >> 2) + 4 * n + (i & 3); }

struct Unit { int pm, pn; int k0 = 0; int nt = 0; };
struct Gemm { const bf16_t* A; const bf16_t* Bt; int M, N, K; int nt; };

struct StaticOrder {
    int nM, nN, nwg, G, c;
    __host__ __device__ void init(int M, int N, int G_, int c_) { nM = M / BM; nN = N / BM; nwg = nM * nN; G = G_; c = c_; }
    __host__ __device__ bool next(int i, Unit& u) const {
        const long L = (long)i * G + c; if (L >= nwg) return false;
        int wgid = (int)L; { const int q = nwg / NXCD, r = nwg % NXCD, xcd = wgid % NXCD, off = wgid / NXCD; wgid = (xcd < r ? xcd * (q + 1) : r * (q + 1) + (xcd - r) * q) + off; }
        const int nig = WGM * nN, gid = wgid / nig, fm = gid * WGM, gsz = (nM - fm) < WGM ? (nM - fm) : WGM;
        u.pm = fm + ((wgid % nig) % gsz); u.pn = (wgid % nig) / gsz; return true;
    }
    __device__ __forceinline__ void a_ready(const Unit&) const {}
    __device__ __forceinline__ void done(const Unit&) const {}
};

__device__ __forceinline__ unsigned cvt_pk_bf16(float lo, float hi) { unsigned r; asm volatile("v_cvt_pk_bf16_f32 %0, %1, %2" : "=v"(r) : "v"(lo), "v"(hi)); return r; }

template <class Epi, class Sched, bool ALIGN_EPI = false, bool SP2 = false>
__device__ __forceinline__ void gemm_phase(PG8_LAS unsigned char* lds, const Gemm g, const Sched& S, const Epi& E, const int tid) {
    const int wid = __builtin_amdgcn_readfirstlane(tid >> 6), lane = tid & 63, wr = wid >> 2, wc = wid & 3, fr = lane & 15, fq = lane >> 4;
    const int K = g.K;
    unsigned voffA[2], voffB[2];
#pragma unroll
    for (int i = 0; i < 2; ++i) { int R, C; stage_rc(tid * 16 + i * 8192, R, C); const int Rb = Epi::PERM ? ((R & ~31) + perm32(R & 31)) : R;
        voffA[i] = (unsigned)(R * K + C) * 2u; voffB[i] = (unsigned)(Rb * K + C) * 2u; }
    const size_t kstep = (size_t)(BK * 2);
    const size_t hstep = (size_t)HALF * K * 2;
    const size_t tstep = 2 * hstep;
    const unsigned ldsw = (unsigned)wid * 1024u;
    const int aoff = lds_byte(wr * 64 + fr, fq * 8), boff = lds_byte(wc * 32 + fr, fq * 8);
#define PG8_SA(b, h) (((b) * 2 + (h)) * HTB)
#define PG8_SB(b, h) ((4 + (b) * 2 + (h)) * HTB)
#define PG8_STAGE(bufoff, gbase, voff) do { _Pragma("unroll") for (int _i = 0; _i < 2; ++_i) \
        __builtin_amdgcn_global_load_lds((const unsigned*)((const char*)(gbase) + (voff)[_i]), (PG8_LAS unsigned*)(lds + (bufoff) + ldsw + _i * 8192), 16, 0, 0); } while (0)
#define PG8_LDA(dst, b, h) do { _Pragma("unroll") for (int m = 0; m < 4; ++m) _Pragma("unroll") for (int k = 0; k < 2; ++k) dst[m][k] = *(const PG8_LAS bf16x8*)(lds + PG8_SA(b, h) + aoff + m * 2048 + k * 1024); } while (0)
#define PG8_LDB(dst, b, h) do { _Pragma("unroll") for (int n = 0; n < 2; ++n) _Pragma("unroll") for (int k = 0; k < 2; ++k) dst[n][k] = *(const PG8_LAS bf16x8*)(lds + PG8_SB(b, h) + boff + n * 2048 + k * 1024); } while (0)
#define PG8_MMA(ai, bj, At, Bt) do { __builtin_amdgcn_s_setprio(1); _Pragma("unroll") for (int m = 0; m < 4; ++m) _Pragma("unroll") for (int n = 0; n < 2; ++n) _Pragma("unroll") for (int k = 0; k < 2; ++k) \
        acc[ai][bj][m][n] = __builtin_amdgcn_mfma_f32_16x16x32_bf16(Bt[n][k], At[m][k], acc[ai][bj][m][n], 0, 0, 0); __builtin_amdgcn_s_setprio(0); } while (0)
#define PG8_WAIT_V(n) asm volatile("s_waitcnt vmcnt(" #n ")" ::: "memory")
#define PG8_WAIT_L(n) asm volatile("s_waitcnt lgkmcnt(" #n ")" ::: "memory")
#define PG8_BAR __builtin_amdgcn_s_barrier()
#define PG8_SCHED __builtin_amdgcn_sched_barrier(0)
    Unit cur, nxt; int ui = 0;
    if (!S.next(0, cur)) return;
    f32x4 acc[2][2][4][2];
#pragma unroll
    for (int a = 0; a < 2; ++a)
#pragma unroll
        for (int b = 0; b < 2; ++b)
#pragma unroll
            for (int m = 0; m < 4; ++m)
#pragma unroll
                for (int n = 0; n < 2; ++n) acc[a][b][m][n] = (f32x4){0.f, 0.f, 0.f, 0.f};
    bf16x8 At[4][2], B0[2][2], B1[2][2];
    const char* cA = (const char*)g.A + (size_t)cur.pm * tstep + (size_t)cur.k0 * 2; const char* cB = (const char*)g.Bt + (size_t)cur.pn * tstep + (size_t)cur.k0 * 2;
    S.a_ready(cur);
    if constexpr (SP2) {
        PG8_STAGE(PG8_SB(0, 0), cB, voffB); PG8_STAGE(PG8_SB(0, 1), cB + hstep, voffB); PG8_STAGE(PG8_SA(0, 0), cA, voffA); PG8_STAGE(PG8_SA(0, 1), cA + hstep, voffA);
        if (wr == 1) PG8_BAR;
        PG8_WAIT_V(2); PG8_BAR;
        PG8_STAGE(PG8_SB(1, 0), cB + kstep, voffB); PG8_STAGE(PG8_SA(1, 0), cA + kstep, voffA); PG8_STAGE(PG8_SB(1, 1), cB + hstep + kstep, voffB);
        PG8_WAIT_V(6); PG8_BAR;
    } else {
        PG8_STAGE(PG8_SB(0, 0), cB, voffB); PG8_STAGE(PG8_SA(0, 0), cA, voffA); PG8_STAGE(PG8_SB(0, 1), cB + hstep, voffB); PG8_STAGE(PG8_SA(0, 1), cA + hstep, voffA);
        if (wr == 1) PG8_BAR;
        PG8_WAIT_V(4); PG8_BAR;
        PG8_STAGE(PG8_SB(1, 0), cB + kstep, voffB); PG8_STAGE(PG8_SA(1, 0), cA + kstep, voffA); PG8_STAGE(PG8_SB(1, 1), cB + hstep + kstep, voffB);
        PG8_WAIT_V(6); PG8_BAR;
    }
    for (;;) {
        const bool has_next = S.next(ui + 1, nxt);
        const int nt = cur.nt ? cur.nt : g.nt;
        const char* nA = has_next ? (const char*)g.A + (size_t)nxt.pm * tstep + (size_t)nxt.k0 * 2 : cA; const char* nB = has_next ? (const char*)g.Bt + (size_t)nxt.pn * tstep + (size_t)nxt.k0 * 2 : cB;
        for (int t = 0; t < nt; t += 2) {
            const bool last = (t == nt - 2);
            const char* a1 = cA + (size_t)(t + 1) * kstep;
            const char* a2 = last ? nA : cA + (size_t)(t + 2) * kstep; const char* b2 = last ? nB : cB + (size_t)(t + 2) * kstep;
            const char* a3 = a2 + kstep; const char* b3 = b2 + kstep;
            if (last && has_next) S.a_ready(nxt);
            if constexpr (SP2) {
            PG8_LDB(B0, 0, 0); PG8_LDB(B1, 0, 1); PG8_SCHED; PG8_LDA(At, 0, 0); PG8_STAGE(PG8_SA(1, 1), a1 + hstep, voffA);
            PG8_WAIT_V(8); PG8_WAIT_L(0); PG8_BAR; PG8_MMA(0, 0, At, B0); PG8_MMA(0, 1, At, B1); PG8_BAR; PG8_SCHED;
            PG8_LDA(At, 0, 1); PG8_STAGE(PG8_SB(0, 0), b2, voffB); PG8_STAGE(PG8_SB(0, 1), b2 + hstep, voffB); PG8_STAGE(PG8_SA(0, 0), a2, voffA);
            PG8_WAIT_V(8); PG8_WAIT_L(0); PG8_BAR; PG8_MMA(1, 0, At, B0); PG8_MMA(1, 1, At, B1); PG8_BAR; PG8_SCHED;
            PG8_LDB(B0, 1, 0); PG8_LDB(B1, 1, 1); PG8_SCHED; PG8_LDA(At, 1, 0); PG8_STAGE(PG8_SA(0, 1), a2 + hstep, voffA);
            PG8_WAIT_V(8); PG8_WAIT_L(0); PG8_BAR; PG8_MMA(0, 0, At, B0); PG8_MMA(0, 1, At, B1); PG8_BAR; PG8_SCHED;
            PG8_LDA(At, 1, 1); PG8_STAGE(PG8_SB(1, 0), b3, voffB); PG8_STAGE(PG8_SB(1, 1), b3 + hstep, voffB); PG8_STAGE(PG8_SA(1, 0), a3, voffA);
            PG8_WAIT_V(8); PG8_WAIT_L(0); PG8_BAR; PG8_MMA(1, 0, At, B0); PG8_MMA(1, 1, At, B1); PG8_BAR; PG8_SCHED;
            } else {
            PG8_LDB(B0, 0, 0); PG8_SCHED; PG8_LDA(At, 0, 0); PG8_STAGE(PG8_SA(1, 1), a1 + hstep, voffA);
            PG8_WAIT_L(8); PG8_BAR; PG8_WAIT_L(0); PG8_MMA(0, 0, At, B0); PG8_BAR; PG8_SCHED;
            PG8_LDB(B1, 0, 1); PG8_STAGE(PG8_SB(0, 0), b2, voffB);
            PG8_BAR; PG8_WAIT_L(0); PG8_MMA(0, 1, At, B1); PG8_BAR;
            PG8_LDA(At, 0, 1); PG8_STAGE(PG8_SA(0, 0), a2, voffA);
            PG8_BAR; PG8_WAIT_L(0); PG8_MMA(1, 0, At, B0); PG8_BAR; PG8_SCHED;
            PG8_STAGE(PG8_SB(0, 1), b2 + hstep, voffB);
            PG8_WAIT_V(6); PG8_BAR; PG8_MMA(1, 1, At, B1); PG8_BAR;
            PG8_LDB(B0, 1, 0); PG8_SCHED; PG8_LDA(At, 1, 0); PG8_STAGE(PG8_SA(0, 1), a2 + hstep, voffA);
            PG8_WAIT_L(8); PG8_BAR; PG8_WAIT_L(0); PG8_MMA(0, 0, At, B0); PG8_BAR; PG8_SCHED;
            PG8_LDB(B1, 1, 1); PG8_STAGE(PG8_SB(1, 0), b3, voffB);
            PG8_BAR; PG8_WAIT_L(0); PG8_MMA(0, 1, At, B1); PG8_BAR;
            PG8_LDA(At, 1, 1); PG8_STAGE(PG8_SA(1, 0), a3, voffA);
            PG8_BAR; PG8_WAIT_L(0); PG8_MMA(1, 0, At, B0); PG8_BAR; PG8_SCHED;
            PG8_STAGE(PG8_SB(1, 1), b3 + hstep, voffB);
            PG8_WAIT_V(6); PG8_BAR; PG8_MMA(1, 1, At, B1); PG8_BAR;
            }
        }
        if constexpr (ALIGN_EPI) { if (wr == 0) PG8_BAR; }
        if constexpr (!Epi::AFTER_DRAIN) { E(acc, cur, wr, wc, fr, fq); S.done(cur); }
        if (!has_next) break;
#pragma unroll
        for (int a = 0; a < 2; ++a)
#pragma unroll
            for (int b = 0; b < 2; ++b)
#pragma unroll
                for (int m = 0; m < 4; ++m)
#pragma unroll
                    for (int n = 0; n < 2; ++n) acc[a][b][m][n] = (f32x4){0.f, 0.f, 0.f, 0.f};
        cur = nxt; cA = nA; cB = nB; ++ui;
        if constexpr (ALIGN_EPI) { if (wr == 1) PG8_BAR; }
    }
    PG8_WAIT_V(0);
    if constexpr (!ALIGN_EPI) { if (wr == 0) PG8_BAR; }
    PG8_BAR;
    if constexpr (Epi::AFTER_DRAIN) { E.fused(acc, cur, wr, wc, fr, fq, lds, wid, lane); S.done(cur); }
#undef PG8_SA
#undef PG8_SB
#undef PG8_STAGE
#undef PG8_LDA
#undef PG8_LDB
#undef PG8_MMA
#undef PG8_WAIT_V
#undef PG8_WAIT_L
#undef PG8_BAR
#undef PG8_SCHED
}
}
#define LAS __attribute__((address_space(3)))
typedef unsigned short bf16_t;
typedef short bf16x8 __attribute__((ext_vector_type(8)));
typedef float f32x4 __attribute__((ext_vector_type(4)));
typedef float f32x2 __attribute__((ext_vector_type(2)));
typedef float f32x16 __attribute__((ext_vector_type(16)));
typedef unsigned u32x4 __attribute__((ext_vector_type(4)));
typedef unsigned u32x2 __attribute__((ext_vector_type(2)));
typedef __bf16 bf16x2_t __attribute__((ext_vector_type(2)));

constexpr int DM = 1024, NB = 4, SEQ = 4096, CTX = 256, RPB = SEQ + CTX  , MROWS = NB * RPB  ;
constexpr int DFF = 2816, INW = 1280, NMOD = 9, DEPTH = 4, NRB = RPB / 256  ;
constexpr float EPS = 1e-6f;
constexpr float C2 = 0.125f * 1.4426950408889634f;
constexpr int LDS_BYTES = 147456;

constexpr size_t al256(size_t x) { return (x + 255) & ~(size_t)255; }
constexpr size_t WS_WGU = 0;
constexpr size_t WS_WD = WS_WGU + al256((size_t)DEPTH * 2 * 5632 * 1024 * 2);
constexpr size_t WS_WIN = WS_WD + al256((size_t)DEPTH * 2 * 1024 * 2816 * 2);
constexpr size_t WS_WOUT = WS_WIN + al256((size_t)DEPTH * 1280 * 1024 * 2);
constexpr size_t WS_MODS = WS_WOUT + al256((size_t)DEPTH * 1024 * 1024 * 2);
constexpr size_t WS_X = WS_MODS + al256((size_t)DEPTH * 5 * 9216 * 4);
constexpr size_t WS_A = WS_X + al256((size_t)MROWS * 1024 * 4);
constexpr size_t WS_H = WS_A + al256((size_t)MROWS * 1024 * 2);
constexpr size_t WS_P = WS_H + al256((size_t)MROWS * DFF * 2);
constexpr size_t WS_Q = WS_P + al256((size_t)MROWS * INW * 2);
constexpr size_t WS_K = WS_Q + al256((size_t)MROWS * 512 * 2);
constexpr size_t WS_VT = WS_K + al256((size_t)NB * 2 * RPB * 64 * 2);
constexpr size_t WS_O = WS_VT + al256((size_t)NB * 2 * RPB * 64 * 2);
constexpr size_t WS_SSMO = WS_O + al256((size_t)MROWS * 512 * 2);
constexpr size_t WS_WE = WS_SSMO + al256((size_t)MROWS * 256 * 4);
constexpr size_t WS_WC = WS_WE + al256((size_t)DEPTH * 2 * 16 * 128 * 256 * 2);
constexpr size_t WS_KC = WS_WC + al256((size_t)DEPTH * 2 * 16 * 16 * 16 * 128 * 2);
constexpr size_t WS_A16 = WS_KC + al256((size_t)DEPTH * 16 * 31 * 256 * 2);
constexpr size_t WS_A256 = WS_A16 + al256((size_t)DEPTH * 2 * 16 * 64 * 8);
constexpr size_t WS_EB = WS_A256 + al256((size_t)DEPTH * 2 * 16 * 64 * 8);
constexpr size_t WS_BAR = WS_EB + al256((size_t)NB * 2 * 16 * NRB * 128 * 4);
constexpr size_t WS_PART = WS_BAR + 16384;
constexpr size_t WS_SPL = WS_PART + (size_t)11 * 1024 * 1024 * 4;
constexpr size_t WS_END = WS_SPL + (size_t)NB * 2 * 16 * NRB * 16 * 128 * 2;
constexpr int LDS_ST_OFF = 147200;

struct Params { const float* in[29]; float* out; unsigned char* ws; };

__device__ __forceinline__ float bf2f(unsigned short h) { return __builtin_bit_cast(float, (unsigned)h << 16); }
__device__ __forceinline__ unsigned pk2(float lo, float hi) { f32x2 v = {lo, hi}; bf16x2_t b = __builtin_convertvector(v, bf16x2_t); return __builtin_bit_cast(unsigned, b); }
__device__ __forceinline__ unsigned short f2bf(float f) { return (unsigned short)(pk2(f, 0.f) & 0xffffu); }
__device__ __forceinline__ float shx(float v, int mask, int lane) { return __builtin_bit_cast(float, __builtin_amdgcn_ds_bpermute((lane ^ mask) << 2, __builtin_bit_cast(int, v))); }
__device__ __forceinline__ float wave_sum(float v, int lane) {
#pragma unroll
    for (int o = 1; o < 64; o <<= 1) v += shx(v, o, lane);
    return v;
}
__device__ __forceinline__ int hw_lane() { int l; asm volatile("v_mbcnt_lo_u32_b32 %0, -1, 0\n\tv_mbcnt_hi_u32_b32 %0, -1, %0" : "=v"(l)); return l; }
#define LDS_WAIT() asm volatile("s_waitcnt lgkmcnt(0)" ::: "memory")
__device__ __forceinline__ float fast_exp2(float x) { return __builtin_amdgcn_exp2f(x); }
__device__ __forceinline__ float fast_rcp(float x) { return __builtin_amdgcn_rcpf(x); }
__device__ __forceinline__ float sigmoidf_(float x) { return fast_rcp(1.f + fast_exp2(-1.4426950408889634f * x)); }
__device__ __forceinline__ float siluf_(float x) { return x * sigmoidf_(x); }
__device__ __forceinline__ void cossin_rev(double rev, float& c, float& s) {
    rev -= __builtin_rint(rev); const float fr = (float)rev; c = __builtin_amdgcn_cosf(fr); s = __builtin_amdgcn_sinf(fr);
}

using pg8::Unit;
struct EpiSwiGLU {
    static constexpr bool PERM = true, AFTER_DRAIN = false;
    bf16_t* H;
    __device__ __forceinline__ void operator()(const f32x4 (&acc)[2][2][4][2], const Unit& u, int wr, int wc, int fr, int fq) const {
        const int row0 = u.pm * 256 + wr * 64 + fr, col0 = u.pn * 128 + wc * 32 + 8 * fq;
#pragma unroll
        for (int ai = 0; ai < 2; ++ai)
#pragma unroll
            for (int m = 0; m < 4; ++m) {
                bf16_t* rowp = H + (size_t)(row0 + ai * 128 + m * 16) * DFF + col0;
                float h[8];
#pragma unroll
                for (int n = 0; n < 2; ++n)
#pragma unroll
                    for (int j = 0; j < 4; ++j) h[4 * n + j] = siluf_(acc[ai][0][m][n][j]) * acc[ai][1][m][n][j];
                u32x4 w; w.x = pk2(h[0], h[1]); w.y = pk2(h[2], h[3]); w.z = pk2(h[4], h[5]); w.w = pk2(h[6], h[7]);
                *(u32x4*)rowp = w;
            }
    }
};
struct EpiP {
    static constexpr bool PERM = true, AFTER_DRAIN = false;
    bf16_t* P;
    __device__ __forceinline__ void operator()(const f32x4 (&acc)[2][2][4][2], const Unit& u, int wr, int wc, int fr, int fq) const {
        const int row0 = u.pm * 256 + wr * 64 + fr, col0 = u.pn * 256 + wc * 32 + 8 * fq;
#pragma unroll
        for (int ai = 0; ai < 2; ++ai)
#pragma unroll
            for (int m = 0; m < 4; ++m)
#pragma unroll
                for (int bj = 0; bj < 2; ++bj) {
                    const f32x4 v0 = acc[ai][bj][m][0], v1 = acc[ai][bj][m][1];
                    u32x4 w; w.x = pk2(v0[0], v0[1]); w.y = pk2(v0[2], v0[3]); w.z = pk2(v1[0], v1[1]); w.w = pk2(v1[2], v1[3]);
                    *(u32x4*)(P + (size_t)(row0 + ai * 128 + m * 16) * INW + col0 + bj * 128) = w;
                }
    }
};
struct EpiResid {
    static constexpr bool PERM = true, AFTER_DRAIN = false;
    float* X; const float* modl; int goff; float coef;
    __device__ __forceinline__ void operator()(const f32x4 (&acc)[2][2][4][2], const Unit& u, int wr, int wc, int fr, int fq) const {
        const int row0 = u.pm * 256 + wr * 64 + fr;
        const int b = u.pm / NRB, mi = (u.pm % NRB == 0) ? 4 : b;
        const float* gp = modl + (size_t)mi * (NMOD * DM) + goff + u.pn * 256 + wc * 32 + 8 * fq;
        f32x4 gv[2][2];
#pragma unroll
        for (int bj = 0; bj < 2; ++bj)
#pragma unroll
            for (int n = 0; n < 2; ++n) gv[bj][n] = *(const f32x4*)(gp + bj * 128 + 4 * n) * coef;
#pragma unroll
        for (int ai = 0; ai < 2; ++ai)
#pragma unroll
            for (int m = 0; m < 4; ++m) {
                float* rp = X + (size_t)(row0 + ai * 128 + m * 16) * DM + u.pn * 256 + wc * 32 + 8 * fq;
#pragma unroll
                for (int bj = 0; bj < 2; ++bj)
#pragma unroll
                    for (int n = 0; n < 2; ++n) { f32x4* p = (f32x4*)(rp + bj * 128 + 4 * n); f32x4 x = *p; x += gv[bj][n] * acc[ai][bj][m][n]; *p = x; }
            }
    }
};

struct EpiResidBoth {
    static constexpr bool PERM = true, AFTER_DRAIN = false;
    float* X; float* PART; const float* modl; int goff; float coef; const float* xin  ;
    __device__ __forceinline__ void operator()(const f32x4 (&acc)[2][2][4][2], const Unit& u, int wr, int wc, int fr, int fq) const {
        const int b = u.pm / NRB; const bool isctx = (u.pm % NRB == 0); const int mi = isctx ? 4 : b;
        const float* gp = modl + (size_t)mi * (NMOD * DM) + goff + u.pn * 256 + wc * 32 + 8 * fq;
        f32x4 gv[2][2];
#pragma unroll
        for (int bj = 0; bj < 2; ++bj)
#pragma unroll
            for (int n = 0; n < 2; ++n) gv[bj][n] = *(const f32x4*)(gp + bj * 128 + 4 * n) * coef;
        float* base = X + (size_t)(u.pm * 256 + wr * 64 + fr) * DM;
        base += u.pn * 256 + wc * 32 + 8 * fq;
        if (isctx) {
            bf16_t* pb = (bf16_t*)PART + ((size_t)(u.k0 >> 8) * 1024 + b * 256 + wr * 64 + fr) * DM + u.pn * 256 + wc * 32 + 8 * fq;
#pragma unroll
            for (int ai = 0; ai < 2; ++ai)
#pragma unroll
                for (int m = 0; m < 4; ++m)
#pragma unroll
                    for (int bj = 0; bj < 2; ++bj) { const f32x4 v0 = gv[bj][0] * acc[ai][bj][m][0], v1 = gv[bj][1] * acc[ai][bj][m][1];
                        u32x4 w; w.x = pk2(v0[0], v0[1]); w.y = pk2(v0[2], v0[3]); w.z = pk2(v1[0], v1[1]); w.w = pk2(v1[2], v1[3]);
                        *(u32x4*)(pb + (size_t)(ai * 128 + m * 16) * DM + bj * 128) = w; }
            return;
        }
        const float* rbase = (xin != nullptr && !isctx) ? xin + (size_t)(u.pm * 256 + wr * 64 + fr - (b + 1) * CTX) * DM + u.pn * 256 + wc * 32 + 8 * fq : base;
#pragma unroll
        for (int ai = 0; ai < 2; ++ai)
#pragma unroll
            for (int m = 0; m < 4; ++m) {
                float* rp = base + (size_t)(ai * 128 + m * 16) * DM; const float* rr = rbase + (size_t)(ai * 128 + m * 16) * DM;
#pragma unroll
                for (int bj = 0; bj < 2; ++bj)
#pragma unroll
                    for (int n = 0; n < 2; ++n) { f32x4 v = gv[bj][n] * acc[ai][bj][m][n]; if (!isctx) v += *(const f32x4*)(rr + bj * 128 + 4 * n); *(f32x4*)(rp + bj * 128 + 4 * n) = v; }
            }
    }
};
struct ResidOrder {
    pg8::StaticOrder S; int nS, G, c;
    __device__ void init(int K, int G_, int c_, bool noctx) { S.init(NB * SEQ, 1024, G_, c_); nS = noctx ? 0 : K / 256; G = G_; c = c_; }
    __device__ bool next(int i, Unit& u) const {
        const int idx = i * G + c;
        if (idx < 256) { S.next(i, u); u.pm = u.pm + (u.pm >> 4) + 1; u.k0 = 0; u.nt = 0; return true; }
        const int L = idx - 256; if (L >= 16 * nS) return false;
        const int ks = L >> 4, r = L & 15;
        const int bb = (r & 7) >> 1; u.pm = bb * NRB; u.pn = (r & 1) + 2 * (r >> 3); u.k0 = ks * 256; u.nt = 4; return true; }
    __device__ __forceinline__ void a_ready(const Unit&) const {}
    __device__ __forceinline__ void done(const Unit&) const {}
};
#define XB_TMO      128
#define XB_XCNT(j)  (256  + 64 * (j))
#define XB_XSUB(j)  (1280 + 64 * (j))
#define XB_XGEN(j)  (2304 + 64 * (j))
#define XB_TOP      3328
#define XB_TOPGEN   3392
#define XCD_BAR_WORDS 3456
#define XB_SPIN_CAP (1u << 18)

__device__ __forceinline__ unsigned xb_ld(unsigned* p)              { return __hip_atomic_load(p, __ATOMIC_RELAXED, __HIP_MEMORY_SCOPE_AGENT); }
__device__ __forceinline__ unsigned xb_add(unsigned* p, unsigned v) { return __hip_atomic_fetch_add(p, v, __ATOMIC_RELAXED, __HIP_MEMORY_SCOPE_AGENT); }
__device__ __forceinline__ unsigned xb_xcc_id() { return (unsigned)__builtin_amdgcn_s_getreg((3 << 11) | 20) & 0xFu; }
#define XB_SPIN(cond, bar) do { unsigned _sp = 0; while (cond) { __builtin_amdgcn_s_sleep(1); \
    if ((++_sp & 255u) == 0u) { if (xb_ld(&(bar)[XB_TMO])) break; if (_sp > XB_SPIN_CAP) { atomicAdd(&(bar)[XB_TMO], 1u); break; } } } } while (0)

struct XcdBarrier {
    unsigned* bar; unsigned x;
    volatile LAS unsigned* st;
};

__device__ __forceinline__ XcdBarrier xcd_barrier_post(unsigned* bar, volatile LAS unsigned* st, int tid) {
    XcdBarrier b; b.bar = bar; b.x = xb_xcc_id(); b.st = st;
    if (tid == 0) (void)xb_add(&bar[XB_XCNT(b.x)], 1u);
    return b;
}
__device__ __forceinline__ void xcd_barrier_complete(unsigned* bar, unsigned x, unsigned& nloc, unsigned& nx) {
    const unsigned G = gridDim.x * gridDim.y * gridDim.z;
    unsigned sum, cnt, mine, sp = 0u;
    for (;;) {
        sum = 0u; cnt = 0u; mine = 0u;
#pragma unroll
        for (unsigned j = 0; j < 16; ++j) { const unsigned c = xb_ld(&bar[XB_XCNT(j)]); sum += c; cnt += (c > 0u) ? 1u : 0u; mine = (j == x) ? c : mine; }
        if (sum == G) break;
        __builtin_amdgcn_s_sleep(1);
        if ((++sp & 255u) == 0u) { if (xb_ld(&bar[XB_TMO])) break; if (sp > XB_SPIN_CAP) { atomicAdd(&bar[XB_TMO], 1u); break; } }
    }
    nloc = mine > 0u ? mine : 1u; nx = cnt > 0u ? cnt : 1u;
}

__device__ __forceinline__ void xcd_barrier(const XcdBarrier& b, int tid) {
    asm volatile("s_waitcnt vmcnt(0)" ::: "memory");
    __syncthreads();
    if (tid == 0) {
        unsigned* bar = b.bar;
        __builtin_amdgcn_s_waitcnt(0);
        unsigned nloc = b.st[0], nx = b.st[1];
        if (nloc == 0u) { xcd_barrier_complete(bar, b.x, nloc, nx); b.st[0] = nloc; b.st[1] = nx; }
        const unsigned old = xb_add(&bar[XB_XSUB(b.x)], 1u);
        const unsigned gen = old / nloc;
        if (old + 1u == (gen + 1u) * nloc) {
            __builtin_amdgcn_fence(__ATOMIC_RELEASE, "agent");
            asm volatile("s_waitcnt vmcnt(0)" ::: "memory");
            const unsigned og = xb_add(&bar[XB_TOP], 1u);
            const unsigned tg = og / nx;
            if (og + 1u == (tg + 1u) * nx) xb_add(&bar[XB_TOPGEN], 1u);
            else XB_SPIN(xb_ld(&bar[XB_TOPGEN]) == tg, bar);
            __builtin_amdgcn_fence(__ATOMIC_ACQUIRE, "agent");
            xb_add(&bar[XB_XGEN(b.x)], 1u);
            asm volatile("s_waitcnt vmcnt(0)" ::: "memory");
        } else {
            XB_SPIN(xb_ld(&bar[XB_XGEN(b.x)]) == gen, bar);
            __builtin_amdgcn_fence(__ATOMIC_ACQUIRE, "agent");
            asm volatile("s_waitcnt vmcnt(0)" ::: "memory");
        }
    }
    __syncthreads();
}

struct Ctx {
    const Params* p;
    LAS unsigned char* lds;
    int tid, lane, wave, G, bid;
    __device__ __forceinline__ const float* in(int i) const { return p->in[i]; }
    __device__ __forceinline__ float* out() const { return p->out; }
#define WSP(T, NAME, OFF) __device__ __forceinline__ T* NAME() const { return (T*)(p->ws + OFF); }
    WSP(bf16_t, WGU, WS_WGU) WSP(bf16_t, WD, WS_WD) WSP(bf16_t, WIN, WS_WIN) WSP(bf16_t, WOUT, WS_WOUT) WSP(bf16_t, A, WS_A) WSP(bf16_t, H, WS_H) WSP(bf16_t, P, WS_P)
    WSP(bf16_t, Q, WS_Q) WSP(bf16_t, Kb, WS_K) WSP(bf16_t, Vt, WS_VT) WSP(bf16_t, O, WS_O) WSP(bf16_t, WE, WS_WE) WSP(bf16_t, WC, WS_WC) WSP(bf16_t, KC, WS_KC)
    WSP(float, MODS, WS_MODS) WSP(float, X, WS_X) WSP(float, SSMO, WS_SSMO) WSP(float, EB, WS_EB) WSP(float, PART, WS_PART) WSP(bf16_t, SPL, WS_SPL) WSP(f32x2, A16, WS_A16) WSP(f32x2, A256, WS_A256)
#undef WSP
};
enum { I_X = 0, I_C, I_CTX, I_CCTX, I_WADA, I_BADA, I_NSUB, I_WG, I_WU, I_WDN, I_WIN, I_WOUT, I_QN, I_KN, I_AON, I_SON, I_PW, I_PS,
       I_LRE, I_LIM, I_LDT, I_BRE, I_BIM, I_CRE, I_CIM, I_SD, I_GW, I_GB, I_FN };

__device__ __forceinline__ void transpose_item(const float* W, int K, int N, bf16_t* WT, int kb, int n0, int drow0, LAS float* scr, int lane) {
    const int k0 = 64 * kb;
    float wv[32];
#pragma unroll
    for (int i = 0; i < 32; ++i) wv[i] = W[(size_t)(k0 + 2 * i + (lane >> 5)) * N + n0 + (lane & 31)];
#pragma unroll
    for (int i = 0; i < 32; ++i) scr[(2 * i + (lane >> 5)) * 33 + (lane & 31)] = wv[i];
    LDS_WAIT();
    const int c = lane & 7;
#pragma unroll
    for (int j = 0; j < 4; ++j) { const int n = (lane >> 3) + 8 * j; const LAS float* s = scr + (8 * c) * 33 + n;
        u32x4 o; o.x = pk2(s[0 * 33], s[1 * 33]); o.y = pk2(s[2 * 33], s[3 * 33]); o.z = pk2(s[4 * 33], s[5 * 33]); o.w = pk2(s[6 * 33], s[7 * 33]);
        *(u32x4*)(WT + (size_t)(drow0 + n) * K + k0 + 8 * c) = o; }
    LDS_WAIT();
}
constexpr int TR_PER_LAYER = 6 * 1408 + 640 + 512;
__device__ __forceinline__ void transpose_layer_item(const Ctx& c, int l, int r, LAS float* scr) {
    if (r < 6 * 1408) { const int mat = r / 1408, rr = r % 1408, type = mat >> 1, lf = l * 2 + (mat & 1);
        if (type < 2) { const int kb = rr / 88, n0 = (rr % 88) * 32;
            transpose_item((type == 0 ? c.in(I_WG) : c.in(I_WU)) + (size_t)lf * 1024 * DFF, 1024, DFF, c.WGU() + (size_t)lf * 5632 * 1024, kb, n0, (n0 >> 7) * 256 + (n0 & 127) + type * 128, scr, c.lane); }
        else { const int kb = rr / 32, n0 = (rr % 32) * 32;
            transpose_item(c.in(I_WDN) + (size_t)lf * DFF * 1024, DFF, 1024, c.WD() + (size_t)lf * 1024 * DFF, kb, n0, n0, scr, c.lane); }
    } else if (r < 6 * 1408 + 640) { const int rr = r - 6 * 1408, kb = rr / 40, n0 = (rr % 40) * 32;
        transpose_item(c.in(I_WIN) + (size_t)l * 1024 * INW, 1024, INW, c.WIN() + (size_t)l * INW * 1024, kb, n0, n0, scr, c.lane);
    } else { const int rr = r - 6 * 1408 - 640, kb = rr / 32, n0 = (rr % 32) * 32;
        transpose_item(c.in(I_WOUT) + (size_t)l * 1024 * 1024, 1024, 1024, c.WOUT() + (size_t)l * 1024 * 1024, kb, n0, n0, scr, c.lane); }
}
struct S5Lam { float lr, li, dt; };
__device__ __forceinline__ S5Lam s5_lam(const Ctx& c, int ldg, int p) { S5Lam r; r.lr = c.in(I_LRE)[ldg * 64 + p]; r.li = c.in(I_LIM)[ldg * 64 + p]; r.dt = expf(c.in(I_LDT)[ldg]); return r; }
__device__ __forceinline__ void s5_pow(const S5Lam& L, int n, float& re, float& im) {
    const float mag = __expf((float)n * L.lr * L.dt); float cs, sn;
    cossin_rev((double)n * (double)L.li * (double)L.dt * 0.15915494309189535, cs, sn); re = mag * cs; im = mag * sn;
}
__device__ __forceinline__ void s5_f(const S5Lam& L, float& fre, float& fim) {
    float are, aim; s5_pow(L, 1, are, aim); const float den = L.lr * L.lr + L.li * L.li;
    fre = ((are - 1.f) * L.lr + aim * L.li) / den; fim = (aim * L.lr - (are - 1.f) * L.li) / den;
}

__device__ __forceinline__ void phase_prep(const Ctx& c) {
    const int gtid = c.bid * 512 + c.tid, NT = c.G * 512;
    const int gw = c.wave * c.G + c.bid, NGW = c.G * 8;
    {
        LAS float* sl = (LAS float*)c.lds;
        LAS float* red = (LAS float*)(c.lds + 20480);
        for (int i = c.tid; i < 5 * 1024; i += 512) { const int ci = i >> 10, k = i & 1023; const float v = (ci < 4) ? c.in(I_C)[ci * 1024 + k] : c.in(I_CCTX)[k]; sl[i] = v / (1.f + __expf(-v)); }
        __syncthreads();
        for (int item = c.bid; item < DEPTH * 144; item += c.G) {
            const int l = item / 144, n = (item % 144) * 64 + c.lane;
            const float* wp = c.in(I_WADA) + ((size_t)l * 1024 + 128 * c.wave) * 9216 + n;
            float acc[5] = {0.f, 0.f, 0.f, 0.f, 0.f};
            for (int kk = 0; kk < 128; kk += 32) {
                float wv[32];
#pragma unroll
                for (int i = 0; i < 32; ++i) wv[i] = wp[(size_t)(kk + i) * 9216];
#pragma unroll
                for (int i = 0; i < 32; ++i)
#pragma unroll
                    for (int ci = 0; ci < 5; ++ci) acc[ci] += sl[ci * 1024 + 128 * c.wave + kk + i] * wv[i];
            }
#pragma unroll
            for (int ci = 0; ci < 5; ++ci) red[(c.wave * 5 + ci) * 64 + c.lane] = acc[ci];
            __syncthreads();
            if (c.tid < 320) { const int ci = c.tid >> 6, ln = c.tid & 63; float s = 0.f;
#pragma unroll
                for (int w = 0; w < 8; ++w) s += red[(w * 5 + ci) * 64 + ln];
                const int nn = (item % 144) * 64 + ln; c.MODS()[((size_t)l * 5 + ci) * 9216 + nn] = s + c.in(I_BADA)[l * 9216 + nn]; }
            __syncthreads();
        }
    }
    { LAS float* scr = (LAS float*)(c.lds + 32768 + c.wave * 8704);
        for (int it = gw; it < TR_PER_LAYER; it += NGW) transpose_layer_item(c, 0, it, scr); }
    for (int ri = gw; ri < NB * CTX; ri += NGW) {
        const int b = ri >> 8, j = ri & 255;
        const f32x4* src = (const f32x4*)(c.in(I_CTX) + ((size_t)b * CTX + j) * DM) + c.lane; f32x4* dst = (f32x4*)(c.X() + ((size_t)b * RPB + j) * DM) + c.lane;
#pragma unroll
        for (int k = 0; k < 4; ++k) dst[64 * k] = src[64 * k];
    }
    for (int i = gtid; i < DEPTH * 2 * 16 * 64 * 16; i += NT) {
        const int kk = i & 15, p = (i >> 4) & 63, ldg = i >> 10, d = (ldg >> 4) & 1;
        const S5Lam L = s5_lam(c, ldg, p); float fre, fim, are, aim; s5_f(L, fre, fim); s5_pow(L, d == 0 ? 15 - kk : kk, are, aim);
        const float wre = are * fre - aim * fim, wim = are * fim + aim * fre;
        const float* br = c.in(I_BRE) + ((size_t)ldg * 64 + p) * 16; const float* bi = c.in(I_BIM) + ((size_t)ldg * 64 + p) * 16;
        unsigned ore[8], oim[8];
#pragma unroll
        for (int h = 0; h < 8; ++h) { const float b0r = br[2 * h], b0i = bi[2 * h], b1r = br[2 * h + 1], b1i = bi[2 * h + 1];
            ore[h] = pk2(wre * b0r - wim * b0i, wre * b1r - wim * b1i); oim[h] = pk2(wre * b0i + wim * b0r, wre * b1i + wim * b1r); }
        u32x4* pr = (u32x4*)(c.WE() + ((size_t)ldg * 128 + p) * 256 + kk * 16); u32x4* pi = (u32x4*)(c.WE() + ((size_t)ldg * 128 + 64 + p) * 256 + kk * 16);
        pr[0] = (u32x4){ore[0], ore[1], ore[2], ore[3]}; pr[1] = (u32x4){ore[4], ore[5], ore[6], ore[7]};
        pi[0] = (u32x4){oim[0], oim[1], oim[2], oim[3]}; pi[1] = (u32x4){oim[4], oim[5], oim[6], oim[7]};
    }
    for (int i = gtid; i < DEPTH * 2 * 16 * 16 * 64; i += NT) {
        const int p = i & 63, tt = (i >> 6) & 15, ldg = i >> 10, d = (ldg >> 4) & 1;
        const S5Lam L = s5_lam(c, ldg, p); float are, aim; s5_pow(L, d == 0 ? tt + 1 : 16 - tt, are, aim);
#pragma unroll 4
        for (int ho = 0; ho < 16; ++ho) { const float cr = c.in(I_CRE)[((size_t)ldg * 16 + ho) * 64 + p], ci = c.in(I_CIM)[((size_t)ldg * 16 + ho) * 64 + p];
            bf16_t* o = c.WC() + (((size_t)ldg * 16 + tt) * 16 + ho) * 128; o[p] = f2bf(cr * are - ci * aim); o[64 + p] = f2bf(-(cr * aim + ci * are)); }
    }
    for (int i4 = gtid; i4 < DEPTH * 16 * 31 * 16 * 4; i4 += NT) {
        const int pq = i4 & 3, i = i4 >> 2;
        const int ho = i & 15, di = (i >> 4) % 31, lg = (i >> 4) / 31, l = lg >> 4, g = lg & 15, delta = di - 15;
        float acc[16];
#pragma unroll
        for (int h = 0; h < 16; ++h) acc[h] = 0.f;
        for (int d = 0; d < 2; ++d) {
            if ((d == 0 && delta < 0) || (d == 1 && delta > 0)) continue;
            const int ldg = (l * 2 + d) * 16 + g, n = delta < 0 ? -delta : delta;
            for (int p = 16 * pq; p < 16 * pq + 16; ++p) {
                const S5Lam L = s5_lam(c, ldg, p); float fre, fim, are, aim; s5_f(L, fre, fim); s5_pow(L, n, are, aim);
                const float cr = c.in(I_CRE)[((size_t)ldg * 16 + ho) * 64 + p], ci = c.in(I_CIM)[((size_t)ldg * 16 + ho) * 64 + p];
                const float t_re = are * fre - aim * fim, t_im = are * fim + aim * fre;
                const float wre = cr * t_re - ci * t_im, wim = cr * t_im + ci * t_re;
                const float* br = c.in(I_BRE) + ((size_t)ldg * 64 + p) * 16; const float* bi = c.in(I_BIM) + ((size_t)ldg * 64 + p) * 16;
#pragma unroll
                for (int h = 0; h < 16; ++h) acc[h] += wre * br[h] - wim * bi[h];
            }
        }
#pragma unroll
        for (int h = 0; h < 16; ++h) { acc[h] += shx(acc[h], 1, c.lane); acc[h] += shx(acc[h], 2, c.lane); }
        if (delta == 0) { const float dsk = c.in(I_SD)[(l * 16 + g) * 16 + ho];
#pragma unroll
            for (int h = 0; h < 16; ++h) acc[h] += (h == ho) ? dsk : 0.f; }
        if (pq == 0) { u32x4* o = (u32x4*)(c.KC() + (((size_t)lg * 31 + di) * 16 + ho) * 16);
            o[0] = (u32x4){pk2(acc[0], acc[1]), pk2(acc[2], acc[3]), pk2(acc[4], acc[5]), pk2(acc[6], acc[7])};
            o[1] = (u32x4){pk2(acc[8], acc[9]), pk2(acc[10], acc[11]), pk2(acc[12], acc[13]), pk2(acc[14], acc[15])}; }
    }
    for (int i = gtid; i < DEPTH * 2 * 16 * 64; i += NT) {
        const S5Lam L = s5_lam(c, i >> 6, i & 63); float re, im; s5_pow(L, 16, re, im); c.A16()[i] = (f32x2){re, im}; s5_pow(L, 256, re, im); c.A256()[i] = (f32x2){re, im};
    }
}

__device__ __forceinline__ void norm_row_load(const Ctx& c, int row, int npend, f32x4 (&v)[4], bool from_input) {
    const int b = row / RPB, j = row - b * RPB;
    const f32x4* xr = (const f32x4*)((from_input && j >= CTX) ? c.in(I_X) + ((size_t)b * SEQ + (j - CTX)) * DM : c.X() + (size_t)row * DM) + c.lane;
#pragma unroll
    for (int k = 0; k < 4; ++k) v[k] = xr[64 * k];
    if (j < CTX && npend > 0) {
        for (int sp = 0; sp < npend; ++sp) { const u32x2* pr = (const u32x2*)((const bf16_t*)c.PART() + ((size_t)sp * 1024 + b * 256 + j) * DM) + c.lane;
#pragma unroll
            for (int k = 0; k < 4; ++k) { const u32x2 w = pr[64 * k]; v[k] += (f32x4){bf2f(w.x & 0xffff), bf2f(w.x >> 16), bf2f(w.y & 0xffff), bf2f(w.y >> 16)}; } }
        f32x4* xw = (f32x4*)(c.X() + (size_t)row * DM) + c.lane;
#pragma unroll
        for (int k = 0; k < 4; ++k) xw[64 * k] = v[k];
    }
}
__device__ __forceinline__ void norm_row_finish(const Ctx& c, int l, int sub, int row, const f32x4 (&v)[4], const float* gamma) {
    const int b = row / RPB, j = row - b * RPB, mi = (j < CTX) ? 4 : b;
    const float* sh = c.MODS() + ((size_t)l * 5 + mi) * (NMOD * DM) + (3 * sub) * DM; const float* sc = sh + DM;
    float s = 0.f;
#pragma unroll
    for (int k = 0; k < 4; ++k) s += (v[k].x * v[k].x + v[k].y * v[k].y) + (v[k].z * v[k].z + v[k].w * v[k].w);
    const float rstd = __builtin_amdgcn_rsqf(wave_sum(s, c.lane) * (1.f / DM) + EPS);
    u32x2* o = (u32x2*)(c.A() + (size_t)row * DM) + c.lane;
#pragma unroll
    for (int k = 0; k < 4; ++k) { const int col = (c.lane + 64 * k) * 4;
        const f32x4 g = *(const f32x4*)(gamma + col), scv = *(const f32x4*)(sc + col), shv = *(const f32x4*)(sh + col);
        const f32x4 y = v[k] * rstd * g * (scv + 1.f) + shv;
        o[64 * k] = (u32x2){pk2(y.x, y.y), pk2(y.z, y.w)}; }
}
__device__ __forceinline__ void phase_norm(const Ctx& c, int l, int sub, int npend) {
    const int gw = c.wave * c.G + c.bid, NGW = c.G * 8;
    const float* gamma = c.in(I_NSUB) + ((size_t)l * 3 + sub) * DM;
    if (c.G == 256) {
        const int x = c.bid & 7, xw = (c.bid >> 3) * 8 + c.wave;
        auto rowof = [&](int j) -> int { if (j < 2048) { const int L = (8 * x + (j >> 8)) * 256 + (j & 255); return (L >> 12) * RPB + CTX + (L & 4095); }
                                         const int cj = (j - 2048) + 128 * x; return (cj >> 8) * RPB + (cj & 255); };
        const bool hasc = xw < 128; const int nrow = hasc ? 9 : 8;
        for (int qi = 0; qi < nrow; qi += 2) {
            const bool two = qi + 1 < nrow;
            const int i0 = hasc ? (qi + 8) % 9 : qi, i1 = hasc ? (qi + 9) % 9 : qi + 1;
            const int j = xw + 256 * i0, j2 = xw + 256 * i1; const int row = rowof(j), row2 = rowof(two ? j2 : j);
            f32x4 v[4], w[4];
            norm_row_load(c, row, npend, v, l == 0 && sub == 0);
            if (two) norm_row_load(c, row2, npend, w, l == 0 && sub == 0);
            norm_row_finish(c, l, sub, row, v, gamma);
            if (two) norm_row_finish(c, l, sub, row2, w, gamma);
        }
        return;
    }
    for (int row = gw; row < MROWS; row += 2 * NGW) {
        const int row2 = row + NGW; const bool two = row2 < MROWS;
        f32x4 v[4], w[4];
        norm_row_load(c, row, npend, v, l == 0 && sub == 0);
        if (two) norm_row_load(c, row2, npend, w, l == 0 && sub == 0);
        norm_row_finish(c, l, sub, row, v, gamma);
        if (two) norm_row_finish(c, l, sub, row2, w, gamma);
    }
}
__device__ __forceinline__ void phase_final(const Ctx& c) {
    const int gw = c.wave * c.G + c.bid, NGW = c.G * 8;
    for (int r = gw; r < NB * SEQ; r += NGW) {
        const int b = r / SEQ, t = r - b * SEQ;
        const f32x4* xr = (const f32x4*)(c.X() + ((size_t)b * RPB + CTX + t) * DM) + c.lane;
        f32x4 v[4]; float s = 0.f;
#pragma unroll
        for (int k = 0; k < 4; ++k) { v[k] = xr[64 * k]; s += (v[k].x * v[k].x + v[k].y * v[k].y) + (v[k].z * v[k].z + v[k].w * v[k].w); }
        const float rstd = __builtin_amdgcn_rsqf(wave_sum(s, c.lane) * (1.f / DM) + EPS);
        f32x4* o = (f32x4*)(c.out() + (size_t)r * DM) + c.lane;
#pragma unroll
        for (int k = 0; k < 4; ++k) o[64 * k] = v[k] * rstd * *(const f32x4*)(c.in(I_FN) + (c.lane + 64 * k) * 4);
    }
}
__device__ __forceinline__ bf16x8 mk8(u32x2 a, u32x2 b) { u32x4 v = {a.x, a.y, b.x, b.y}; return __builtin_bit_cast(bf16x8, v); }
__device__ __forceinline__ f32x4 mfma16(bf16x8 a, bf16x8 b, f32x4 c) { return __builtin_amdgcn_mfma_f32_16x16x32_bf16(a, b, c, 0, 0, 0); }
__device__ __forceinline__ f32x16 mfma32(bf16x8 a, bf16x8 b, f32x16 c) { return __builtin_amdgcn_mfma_f32_32x32x16_bf16(a, b, c, 0, 0, 0); }

__device__ __forceinline__ void s5_states(const Ctx& c, int l, int item, LAS unsigned char* wl, int lane) {
    const int d = item & 1, g = (item >> 1) & 15, rbb = item >> 5, RB = rbb % NRB, b = rbb / NRB;
    const int G = lane & 15, q = lane >> 4;
    const size_t row0 = (size_t)b * RPB + 256 * RB;
    bf16x8 U[8];
#pragma unroll
    for (int ks = 0; ks < 8; ++ks) U[ks] = *(const bf16x8*)(c.P() + (row0 + 16 * G + 2 * ks + (q >> 1)) * INW + 1024 + g * 16 + 8 * (q & 1));
    LAS float* Eb = (LAS float*)wl;
    const int ldg = (l * 2 + d) * 16 + g;
    const bf16_t* we = c.WE() + (size_t)ldg * 128 * 256 + (size_t)G * 256 + 8 * q;
    f32x4 acc[8];
#pragma unroll
    for (int rbE = 0; rbE < 8; ++rbE) acc[rbE] = (f32x4){0.f, 0.f, 0.f, 0.f};
#pragma unroll
    for (int ks = 0; ks < 8; ++ks)
#pragma unroll
        for (int rbE = 0; rbE < 8; ++rbE) acc[rbE] = mfma16(*(const bf16x8*)(we + (size_t)rbE * 16 * 256 + 32 * ks), U[ks], acc[rbE]);
#pragma unroll
    for (int rbE = 0; rbE < 8; ++rbE) *(LAS f32x4*)(Eb + G * 132 + 16 * rbE + 4 * q) = acc[rbE];
    LDS_WAIT();
    const f32x2 a16 = c.A16()[ldg * 64 + lane];
    float sre = 0.f, sim = 0.f;
    const size_t bdg = (size_t)((b * 2 + d) * 16 + g) * NRB + RB;
    bf16_t* spl = c.SPL() + bdg * 16 * 128;
#pragma unroll
    for (int i = 0; i < 16; ++i) { const int Gs = (d == 0) ? i : 15 - i;
        spl[Gs * 128 + lane] = f2bf(sre); spl[Gs * 128 + 64 + lane] = f2bf(sim);
        const float er = Eb[Gs * 132 + lane], ei = Eb[Gs * 132 + 64 + lane];
        const float nr = a16.x * sre - a16.y * sim + er, ni = a16.x * sim + a16.y * sre + ei; sre = nr; sim = ni; }
    float* o = c.EB() + bdg * 128; o[lane] = sre; o[64 + lane] = sim;
    LDS_WAIT();
}
__device__ __forceinline__ void s5_outputs(const Ctx& c, int l, int item, LAS unsigned char* wl, int lane) {
    const int half = item & 1, g = (item >> 1) & 15, rbb = item >> 5, RB = rbb % NRB, b = rbb / NRB;
    const int G = lane & 15, q = lane >> 4;
    const size_t row0 = (size_t)b * RPB + 256 * RB;
    bf16x8 U[8];
#pragma unroll
    for (int ks = 0; ks < 8; ++ks) U[ks] = *(const bf16x8*)(c.P() + (row0 + 16 * G + 2 * ks + (q >> 1)) * INW + 1024 + g * 16 + 8 * (q & 1));
    LAS bf16_t* SP = (LAS bf16_t*)wl;
#pragma unroll
    for (int d = 0; d < 2; ++d) {
        const int ldg = (l * 2 + d) * 16 + g;
        const f32x2 a16 = c.A16()[ldg * 64 + lane], a256 = c.A256()[ldg * 64 + lane];
        const size_t bdg0 = (size_t)((b * 2 + d) * 16 + g) * NRB;
        const float* eb = c.EB() + bdg0 * 128;
        float pre = 0.f, pim = 0.f;
        const int npre = (d == 0) ? RB : (RB == 0 ? 0 : NRB - RB);
        for (int i = 0; i < npre; ++i) { const int rp = (d == 0) ? i : (i == 0 ? 0 : NRB - i);
            const float er = eb[rp * 128 + lane], ei = eb[rp * 128 + 64 + lane];
            const float nr = a256.x * pre - a256.y * pim + er, ni = a256.x * pim + a256.y * pre + ei; pre = nr; pim = ni; }
        const bf16_t* spl = c.SPL() + (bdg0 + RB) * 16 * 128;
        float lr[16], li[16];
#pragma unroll
        for (int i = 0; i < 16; ++i) { lr[i] = bf2f(spl[i * 128 + lane]); li[i] = bf2f(spl[i * 128 + 64 + lane]); }
#pragma unroll
        for (int i = 0; i < 16; ++i) { const int Gs = (d == 0) ? i : 15 - i;
            SP[(d * 16 + Gs) * 136 + lane] = f2bf(lr[Gs] + pre); SP[(d * 16 + Gs) * 136 + 64 + lane] = f2bf(li[Gs] + pim);
            const float nr = a16.x * pre - a16.y * pim, ni = a16.x * pim + a16.y * pre; pre = nr; pim = ni; }
    }
    LDS_WAIT();
    const float* gw = c.in(I_GW) + ((size_t)(l * 16 + g) * 16 + 4 * q) * 16;
    f32x4 Wg[4][4];
#pragma unroll
    for (int jj = 0; jj < 4; ++jj)
#pragma unroll
        for (int k4 = 0; k4 < 4; ++k4) Wg[jj][k4] = *(const f32x4*)(gw + jj * 16 + 4 * k4);
    const f32x4 bias = *(const f32x4*)(c.in(I_GB) + (l * 16 + g) * 16 + 4 * q);
    const bf16_t* kc = c.KC() + (size_t)(l * 16 + g) * 31 * 256 + G * 16 + 8 * (q & 1);
    const bool b0 = (q & 1) != 0, b1 = (q & 2) != 0;
#pragma unroll 2
    for (int t8 = 0; t8 < 8; ++t8) { const int tt = half * 8 + t8;
        f32x4 acc = {0.f, 0.f, 0.f, 0.f};
#pragma unroll
        for (int ks = 0; ks < 8; ++ks) acc = mfma16(*(const bf16x8*)(kc + (tt - (2 * ks + (q >> 1)) + 15) * 256), U[ks], acc);
        f32x4 acc2 = {0.f, 0.f, 0.f, 0.f};
#pragma unroll
        for (int d = 0; d < 2; ++d) {
            const bf16_t* wc = c.WC() + ((((size_t)(l * 2 + d) * 16 + g) * 16 + tt) * 16 + G) * 128 + 8 * q;
#pragma unroll
            for (int ks = 0; ks < 4; ++ks) acc2 = mfma16(*(const bf16x8*)(wc + 32 * ks), *(const LAS bf16x8*)(SP + (d * 16 + G) * 136 + 32 * ks + 8 * q), acc2); }
        acc += acc2;
        float gv[4];
#pragma unroll
        for (int j = 0; j < 4; ++j) { const float x = acc[j]; gv[j] = x * sigmoidf_(1.5957691216057308f * (x + 0.044715f * x * x * x)); }
        f32x4 pz[4];
#pragma unroll
        for (int k4 = 0; k4 < 4; ++k4) pz[k4] = Wg[0][k4] * gv[0] + Wg[1][k4] * gv[1] + Wg[2][k4] * gv[2] + Wg[3][k4] * gv[3];
        f32x4 r8[2];
#pragma unroll
        for (int h2 = 0; h2 < 2; ++h2) { const f32x4 keep = b1 ? pz[2 + h2] : pz[h2], send = b1 ? pz[h2] : pz[2 + h2]; f32x4 rc;
#pragma unroll
            for (int e = 0; e < 4; ++e) rc[e] = shx(send[e], 32, lane);
            r8[h2] = keep + rc; }
        const f32x4 keep = b0 ? r8[1] : r8[0], send = b0 ? r8[0] : r8[1]; f32x4 z;
#pragma unroll
        for (int e = 0; e < 4; ++e) z[e] = keep[e] + shx(send[e], 16, lane);
        f32x4 o;
#pragma unroll
        for (int j = 0; j < 4; ++j) o[j] = gv[j] * sigmoidf_(z[j] + bias[j]);
        *(f32x4*)(c.SSMO() + (row0 + 16 * G + tt) * 256 + g * 16 + 4 * q) = o;
    }
    LDS_WAIT();
}

__device__ __forceinline__ void phase_p1(const Ctx& c, int l) {
    LAS bf16_t* ub = (LAS bf16_t*)c.lds;
    LAS bf16_t* pooled = (LAS bf16_t*)(c.lds + 40960);
    LAS bf16_t* vt = (LAS bf16_t*)(c.lds + 40960 + 33792);
    for (int k_ = 0; ; ++k_) {
        int item;
        if (c.G == 256) { if (k_ == 0) item = c.bid; else if (k_ == 1 && c.bid >= 128 && c.bid < 144) item = 128 + c.bid; else break; }
        else { item = c.bid + k_ * c.G; if (item >= MROWS / 64) break; }
        const int row0 = item * 64, b = row0 / RPB, j0 = row0 - b * RPB;
        const bool lat = j0 >= CTX; const int seg0 = lat ? CTX : 0, segL = lat ? SEQ : CTX, t0 = j0 - seg0;
        for (int i = c.tid; i < 80 * 32; i += 512) { const int r = i >> 5, ch = i & 31, t = t0 - 8 + r;
            u32x4 v = {0u, 0u, 0u, 0u};
            if (t >= 0 && t < segL) v = *(const u32x4*)(c.P() + ((size_t)b * RPB + seg0 + t) * INW + 768 + 8 * ch);
            *(LAS u32x4*)(ub + r * 256 + 8 * ch) = v; }
        for (int i = c.tid; i < 1024; i += 512) { const int r = i >> 4, kv = (i >> 3) & 1, ch = i & 7;
            *(LAS u32x4*)(vt + (kv * 64 + r) * 64 + 8 * ch) = *(const u32x4*)(c.P() + (size_t)(row0 + r) * INW + 640 + kv * 64 + 8 * ch); }
        __syncthreads();
        for (int i = c.tid; i < 1024; i += 512) { const int kv = i >> 9, d = (i >> 3) & 63, ch = i & 7;
            unsigned short e[8];
#pragma unroll
            for (int k = 0; k < 8; ++k) e[k] = vt[(kv * 64 + 8 * ch + k) * 64 + d];
            u32x4 w = {(unsigned)e[0] | ((unsigned)e[1] << 16), (unsigned)e[2] | ((unsigned)e[3] << 16), (unsigned)e[4] | ((unsigned)e[5] << 16), (unsigned)e[6] | ((unsigned)e[7] << 16)};
            *(u32x4*)(c.Vt() + ((size_t)(b * 2 + kv) * 64 + d) * RPB + j0 + 8 * ch) = w; }
        { const int ch = c.tid & 255, th = c.tid >> 8, w = 2 << (ch >> 6), hw = w >> 1;
            const int tl0 = th * 32; float s = 0.f;
            for (int r = tl0 + 8 - hw; r < tl0 + 8 + hw; ++r) s += bf2f(ub[r * 256 + ch]);
#pragma unroll 4
            for (int tl = tl0; tl < tl0 + 32; ++tl) { const int t = t0 + tl;
                const int lo = max(t - hw, 0), hi = min(t + hw, segL);
                pooled[tl * 264 + ch] = f2bf(s * fast_rcp((float)(hi - lo)) - bf2f(ub[(tl + 8) * 256 + ch]));
                s += bf2f(ub[(tl + 8 + hw) * 256 + ch]) - bf2f(ub[(tl + 8 - hw) * 256 + ch]); } }
        __syncthreads();
        { const int g = c.wave >> 1, th = c.wave & 1, G16 = c.lane & 15, q = c.lane >> 4;
            const float* pw = c.in(I_PW) + ((size_t)(l * 4 + g) * 64) * 64 + G16;
            bf16x8 Bf[4][2]; float ps[4];
#pragma unroll
            for (int db = 0; db < 4; ++db) { ps[db] = c.in(I_PS)[l * 256 + g * 64 + 16 * db + G16];
#pragma unroll
                for (int ks = 0; ks < 2; ++ks) { float w8[8];
#pragma unroll
                    for (int j = 0; j < 8; ++j) w8[j] = pw[(size_t)(32 * ks + 8 * q + j) * 64 + 16 * db];
                    u32x4 w = {pk2(w8[0], w8[1]), pk2(w8[2], w8[3]), pk2(w8[4], w8[5]), pk2(w8[6], w8[7])}; Bf[db][ks] = __builtin_bit_cast(bf16x8, w); } }
#pragma unroll
            for (int rb = 0; rb < 2; ++rb) {
                const LAS bf16_t* ap = pooled + (32 * th + 16 * rb + G16) * 264 + g * 64 + 8 * q;
                const bf16x8 A0 = *(const LAS bf16x8*)ap, A1 = *(const LAS bf16x8*)(ap + 32);
                bf16_t* orow = c.A() + (size_t)(row0 + 32 * th + 16 * rb + 4 * q) * DM + 512 + g * 64 + G16;
#pragma unroll
                for (int db = 0; db < 4; ++db) { f32x4 acc = {0.f, 0.f, 0.f, 0.f};
                    acc = mfma16(A0, Bf[db][0], acc); acc = mfma16(A1, Bf[db][1], acc);
#pragma unroll
                    for (int j = 0; j < 4; ++j) orow[(size_t)j * DM + 16 * db] = f2bf(acc[j] * ps[db]); } } }
        __syncthreads();
    }
    const int gw = c.wave * c.G + c.bid, NGW = c.G * 8;
    { const int cq = c.lane & 7, h8 = c.lane >> 3, axis = cq >> 2, half = (cq >> 1) & 1;
        float qg[8], kg[8], inv[8];
#pragma unroll
        for (int i = 0; i < 8; ++i) { qg[i] = c.in(I_QN)[l * 64 + 8 * cq + i] * C2; kg[i] = c.in(I_KN)[l * 64 + 8 * cq + i];
            inv[i] = exp2f(-(float)(8 * (cq & 1) + i) * (13.287712379549449f / 16.f)) * 0.15915494309189535f; }
#define QK_PASS(RAW, ROW, GAM, OUT) do { \
            float v_[8]; v_[0] = bf2f(RAW.x & 0xffff); v_[1] = bf2f(RAW.x >> 16); v_[2] = bf2f(RAW.y & 0xffff); v_[3] = bf2f(RAW.y >> 16); \
            v_[4] = bf2f(RAW.z & 0xffff); v_[5] = bf2f(RAW.z >> 16); v_[6] = bf2f(RAW.w & 0xffff); v_[7] = bf2f(RAW.w >> 16); \
            float ss_ = 0.f; _Pragma("unroll") for (int i = 0; i < 8; ++i) ss_ += v_[i] * v_[i]; \
            ss_ += shx(ss_, 1, c.lane); ss_ += shx(ss_, 2, c.lane); ss_ += shx(ss_, 4, c.lane); \
            const float rs_ = __builtin_amdgcn_rsqf(ss_ * (1.f / 64.f) + EPS); \
            const int j_ = (ROW) % RPB; const bool lat_ = j_ >= CTX; const int t_ = j_ - CTX; const float pos_ = (float)(axis == 0 ? (t_ >> 6) : (t_ & 63)); \
            float y_[8]; _Pragma("unroll") for (int i = 0; i < 8; ++i) y_[i] = v_[i] * rs_ * GAM[i]; \
            _Pragma("unroll") for (int i = 0; i < 8; ++i) { const float ot_ = shx(y_[i], 2, c.lane); float fr_ = pos_ * inv[i]; fr_ -= __builtin_rintf(fr_); \
                const float cs_ = lat_ ? __builtin_amdgcn_cosf(fr_) : 1.f, sn_ = lat_ ? __builtin_amdgcn_sinf(fr_) : 0.f; \
                y_[i] = half == 0 ? y_[i] * cs_ - ot_ * sn_ : y_[i] * cs_ + ot_ * sn_; } \
            OUT = (u32x4){pk2(y_[0], y_[1]), pk2(y_[2], y_[3]), pk2(y_[4], y_[5]), pk2(y_[6], y_[7])}; } while (0)
        for (int r0 = gw; r0 < MROWS; r0 += 4 * NGW) {
            u32x4 rq[4], rk; int rows[4];
#pragma unroll
            for (int i = 0; i < 4; ++i) { rows[i] = (r0 + i * NGW < MROWS) ? r0 + i * NGW : r0; rq[i] = *(const u32x4*)(c.P() + (size_t)rows[i] * INW + h8 * 64 + 8 * cq); }
            const int krow = (r0 + (c.lane >> 4) * NGW < MROWS) ? r0 + (c.lane >> 4) * NGW : r0, kh = h8 & 1;
            rk = *(const u32x4*)(c.P() + (size_t)krow * INW + 512 + kh * 64 + 8 * cq);
#pragma unroll
            for (int i = 0; i < 4; ++i) { u32x4 o; QK_PASS(rq[i], rows[i], qg, o);
                if (i == 0 || r0 + i * NGW < MROWS) *(u32x4*)(c.Q() + (size_t)rows[i] * 512 + h8 * 64 + 8 * cq) = o; }
            { u32x4 o; QK_PASS(rk, krow, kg, o);
                if ((c.lane >> 4) == 0 || r0 + (c.lane >> 4) * NGW < MROWS) { const int b = krow / RPB, j = krow - b * RPB;
                    *(u32x4*)(c.Kb() + ((size_t)(b * 2 + kh) * RPB + j) * 64 + 8 * cq) = o; } }
        }
#undef QK_PASS
    }
    for (int it = gw; it < NB * NRB * 32; it += NGW) s5_states(c, l, it, c.lds + c.wave * 8704, c.lane);
}

__device__ __forceinline__ void attn_unit(const Ctx& c, int u) {
    int b, kvh, qb;
    if (u < 256) { b = u >> 6; kvh = (u >> 5) & 1; qb = 2 + (u & 31); } else { const int v = u - 256; b = v >> 2; kvh = (v >> 1) & 1; qb = v & 1; }
    const int nt = (qb < 2) ? CTX / 64 : RPB / 64;
    const int wid = c.wave, lane = c.lane, tid = c.tid;
    const int hq = kvh * 4 + (wid >> 1), j0 = 128 * qb + 64 * (wid & 1), qc = lane & 31, hi = lane >> 5;
    LAS unsigned char* L = c.lds;
    bf16x8 qf[2][4];
#pragma unroll
    for (int qk = 0; qk < 2; ++qk)
#pragma unroll
        for (int ds = 0; ds < 4; ++ds) qf[qk][ds] = *(const bf16x8*)(c.Q() + ((size_t)b * RPB + j0 + 32 * qk + qc) * 512 + hq * 64 + 16 * ds + 8 * hi);
    const int sr = tid >> 3, sc = tid & 7;
    const bf16_t* Kg = c.Kb() + (size_t)(b * 2 + kvh) * RPB * 64;
    const bf16_t* Vg = c.Vt() + (size_t)(b * 2 + kvh) * 64 * RPB;
    const int koff = sr * 64 + sc * 8, voff = sr * RPB + sc * 8;
    const int soff = (sr * 72 + sc * 8) * 2;
    u32x4 kreg = *(const u32x4*)(Kg + koff), vreg = *(const u32x4*)(Vg + voff);
    const int vsoff = (sr * 72 + 16 * (sc >> 1) + 4 * (sc & 1)) * 2;
    *(LAS u32x4*)(L + soff) = kreg; *(LAS u32x2*)(L + 18432 + vsoff) = (u32x2){vreg.x, vreg.y}; *(LAS u32x2*)(L + 18432 + vsoff + 16) = (u32x2){vreg.z, vreg.w};
    __syncthreads();
    f32x16 O[2][2];
#pragma unroll
    for (int a = 0; a < 2; ++a)
#pragma unroll
        for (int bb = 0; bb < 2; ++bb)
#pragma unroll
            for (int r = 0; r < 16; ++r) O[a][bb][r] = 0.f;
    float mref[2] = {0.f, 0.f}, lsum[2] = {0.f, 0.f};
    bool shifted = false;
#pragma unroll 1
    for (int t = 0; t < nt; ++t) {
        const int cur = t & 1;
        if (t + 1 < nt) { kreg = *(const u32x4*)(Kg + (size_t)(t + 1) * 4096 + koff); vreg = *(const u32x4*)(Vg + (size_t)(t + 1) * 64 + voff); }
        const LAS unsigned char* Kt = L + cur * 9216; const LAS unsigned char* Vt = L + 18432 + cur * 9216;
        f32x16 S[2][2];
#pragma unroll
        for (int kb = 0; kb < 2; ++kb)
#pragma unroll
            for (int ds = 0; ds < 4; ++ds) { const bf16x8 kf = *(const LAS bf16x8*)(Kt + ((32 * kb + qc) * 72 + 16 * ds + 8 * hi) * 2);
#pragma unroll
                for (int qk = 0; qk < 2; ++qk) {
                    if (ds == 0) { f32x16 z;
#pragma unroll
                        for (int r = 0; r < 16; ++r) z[r] = 0.f;
                        S[kb][qk] = mfma32(kf, qf[qk][ds], z); }
                    else S[kb][qk] = mfma32(kf, qf[qk][ds], S[kb][qk]); } }
        if (shifted) {
#pragma unroll
            for (int qk = 0; qk < 2; ++qk)
#pragma unroll
                for (int r = 0; r < 16; ++r) { S[0][qk][r] -= mref[qk]; S[1][qk][r] -= mref[qk]; }
        }
        float mt[2];
#pragma unroll
        for (int qk = 0; qk < 2; ++qk) { float m0 = fmaxf(S[0][qk][0], S[1][qk][0]);
#pragma unroll
            for (int r = 1; r < 16; ++r) m0 = fmaxf(fmaxf(m0, S[0][qk][r]), S[1][qk][r]);
            mt[qk] = m0; }
        if (__builtin_amdgcn_ballot_w64(fmaxf(mt[0], mt[1]) > 8.f) != 0ull) {
#pragma unroll
            for (int qk = 0; qk < 2; ++qk) { const float mo = fmaxf(mt[qk], shx(mt[qk], 32, lane)), up = fmaxf(mo, 0.f), alpha = fast_exp2(-up);
                mref[qk] += up; lsum[qk] *= alpha;
#pragma unroll
                for (int r = 0; r < 16; ++r) { S[0][qk][r] -= up; S[1][qk][r] -= up; O[0][qk][r] *= alpha; O[1][qk][r] *= alpha; } }
            shifted = true;
        }
#pragma unroll
        for (int qk = 0; qk < 2; ++qk) { float ps = 0.f;
#pragma unroll
            for (int kb = 0; kb < 2; ++kb)
#pragma unroll
                for (int r = 0; r < 16; ++r) { const float p = fast_exp2(S[kb][qk][r]); S[kb][qk][r] = p; ps += p; }
            lsum[qk] += ps; }
#pragma unroll
        for (int kb = 0; kb < 2; ++kb)
#pragma unroll
            for (int s2 = 0; s2 < 2; ++s2) { const int s = 2 * kb + s2;
                bf16x8 pb[2];
#pragma unroll
                for (int qk = 0; qk < 2; ++qk) { u32x4 w = {pk2(S[kb][qk][8 * s2 + 0], S[kb][qk][8 * s2 + 1]), pk2(S[kb][qk][8 * s2 + 2], S[kb][qk][8 * s2 + 3]),
                                                           pk2(S[kb][qk][8 * s2 + 4], S[kb][qk][8 * s2 + 5]), pk2(S[kb][qk][8 * s2 + 6], S[kb][qk][8 * s2 + 7])};
                    pb[qk] = __builtin_bit_cast(bf16x8, w); }
#pragma unroll
                for (int db = 0; db < 2; ++db) {
                    const bf16x8 vf = *(const LAS bf16x8*)(Vt + ((32 * db + qc) * 72 + 16 * s + 8 * hi) * 2);
#pragma unroll
                    for (int qk = 0; qk < 2; ++qk) O[db][qk] = mfma32(vf, pb[qk], O[db][qk]); } }
        if (t + 1 < nt) { *(LAS u32x4*)(L + (cur ^ 1) * 9216 + soff) = kreg; *(LAS u32x2*)(L + 18432 + (cur ^ 1) * 9216 + vsoff) = (u32x2){vreg.x, vreg.y}; *(LAS u32x2*)(L + 18432 + (cur ^ 1) * 9216 + vsoff + 16) = (u32x2){vreg.z, vreg.w}; }
        __syncthreads();
    }
    int qc2 = qc, hi2 = hi; asm volatile("" : "+v"(qc2), "+v"(hi2));
#pragma unroll
    for (int qk = 0; qk < 2; ++qk) {
        const float inv = 1.f / (lsum[qk] + shx(lsum[qk], 32, lane));
        bf16_t* orow = c.O() + ((size_t)b * RPB + j0 + 32 * qk + qc2) * 512 + hq * 64 + 4 * hi2;
#pragma unroll
        for (int db = 0; db < 2; ++db)
#pragma unroll
            for (int rg = 0; rg < 4; ++rg)
                *(u32x2*)(orow + 32 * db + 8 * rg) = (u32x2){pk2(O[db][qk][4 * rg] * inv, O[db][qk][4 * rg + 1] * inv), pk2(O[db][qk][4 * rg + 2] * inv, O[db][qk][4 * rg + 3] * inv)};
    }
}
__device__ __forceinline__ void phase_p2(const Ctx& c, int l) {
    { const int gw = c.wave * c.G + c.bid, NGW = c.G * 8;
        if (l == DEPTH - 1) {
            for (int k = gw; k < NB * (NRB - 1) * 32; k += NGW) { const int rb2 = k >> 5, b = rb2 / (NRB - 1), RB = 1 + rb2 % (NRB - 1);
                s5_outputs(c, l, ((b * NRB + RB) << 5) | (k & 31), c.lds + c.wave * 8704, c.lane); }
        } else
        for (int it = gw; it < NB * NRB * 32; it += NGW) s5_outputs(c, l, it, c.lds + c.wave * 8704, c.lane); }
    __syncthreads();
    for (int k_ = 0; ; ++k_) {
        int u;
        if (c.G == 256) { if (k_ == 0) u = (c.bid & 7) * 32 + (c.bid >> 3); else if (k_ == 1 && c.bid >= 128 && c.bid < 144) u = 128 + c.bid; else break; }
        else { u = c.bid + k_ * c.G; if (u >= 272) break; }
        if (u >= 256 && l == DEPTH - 1) break;
        attn_unit(c, u);
    }
}
__device__ __forceinline__ void p3_finish(const Ctx& c, int row, const u32x4 ov, const f32x4 sv, const float* ga, const float* gs) {
    float o[8]; o[0] = bf2f(ov.x & 0xffff); o[1] = bf2f(ov.x >> 16); o[2] = bf2f(ov.y & 0xffff); o[3] = bf2f(ov.y >> 16); o[4] = bf2f(ov.z & 0xffff); o[5] = bf2f(ov.z >> 16); o[6] = bf2f(ov.w & 0xffff); o[7] = bf2f(ov.w >> 16);
    float s = 0.f;
#pragma unroll
    for (int k = 0; k < 8; ++k) s += o[k] * o[k];
    float s2 = sv.x * sv.x + sv.y * sv.y + sv.z * sv.z + sv.w * sv.w;
#pragma unroll
    for (int m = 1; m < 64; m <<= 1) { s += shx(s, m, c.lane); s2 += shx(s2, m, c.lane); }
    const float ra = __builtin_amdgcn_rsqf(s * (1.f / 512.f) + EPS), rs = __builtin_amdgcn_rsqf(s2 * (1.f / 256.f) + EPS);
    const f32x4 g0 = *(const f32x4*)(ga + 8 * c.lane), g1 = *(const f32x4*)(ga + 8 * c.lane + 4);
    *((u32x4*)(c.A() + (size_t)row * DM) + c.lane) = (u32x4){pk2(o[0] * ra * g0.x, o[1] * ra * g0.y), pk2(o[2] * ra * g0.z, o[3] * ra * g0.w), pk2(o[4] * ra * g1.x, o[5] * ra * g1.y), pk2(o[6] * ra * g1.z, o[7] * ra * g1.w)};
    const f32x4 g2 = *(const f32x4*)(gs + 4 * c.lane);
    *((u32x2*)(c.A() + (size_t)row * DM + 768) + c.lane) = (u32x2){pk2(sv.x * rs * g2.x, sv.y * rs * g2.y), pk2(sv.z * rs * g2.z, sv.w * rs * g2.w)};
}
__device__ __forceinline__ void phase_p3(const Ctx& c, int l) {
    const int gw = c.wave * c.G + c.bid, NGW = c.G * 8;
    const float* ga = c.in(I_AON) + l * 512; const float* gs = c.in(I_SON) + l * 256;
    for (int row = gw; row < MROWS; row += 2 * NGW) {
        const int row2 = row + NGW; const bool two = row2 < MROWS; const int r2 = two ? row2 : row;
        const u32x4 ov = *((const u32x4*)(c.O() + (size_t)row * 512) + c.lane); const f32x4 sv = *((const f32x4*)(c.SSMO() + (size_t)row * 256) + c.lane);
        const u32x4 ov2 = *((const u32x4*)(c.O() + (size_t)r2 * 512) + c.lane); const f32x4 sv2 = *((const f32x4*)(c.SSMO() + (size_t)r2 * 256) + c.lane);
        p3_finish(c, row, ov, sv, ga, gs);
        if (two) p3_finish(c, row2, ov2, sv2, ga, gs);
    }
}
__global__ void __launch_bounds__(512, 2) fwd_megakernel(Params p) {
    extern __shared__ __attribute__((aligned(16))) unsigned char lds[];
    cg::grid_group grid = cg::this_grid();
    Ctx c; c.p = &p;
    c.lds = (LAS unsigned char*)lds;
    const int wave_s = __builtin_amdgcn_readfirstlane((int)threadIdx.x >> 6);
#define REFRESH() do { int w_ = wave_s, b_ = blockIdx.x; asm volatile("" : "+s"(w_), "+s"(b_)); c.wave = w_; c.bid = b_; c.lane = hw_lane(); c.tid = w_ * 64 + c.lane; } while (0)
    c.G = gridDim.x; REFRESH();
    if (c.tid < 2) ((LAS unsigned*)(c.lds + LDS_ST_OFF))[c.tid] = 0u;
    __syncthreads();
    (void)xcd_barrier_post((unsigned*)(p.ws + WS_BAR), (volatile LAS unsigned*)(c.lds + LDS_ST_OFF), c.tid);
#define GSYNC() do { XcdBarrier xb_; xb_.bar = (unsigned*)(p.ws + WS_BAR); xb_.x = xb_xcc_id(); xb_.st = (volatile LAS unsigned*)(c.lds + LDS_ST_OFF); xcd_barrier(xb_, c.tid); REFRESH(); } while (0)

    phase_prep(c);
    if (p.ws == nullptr) grid.sync();
    GSYNC();
#pragma unroll 1
    for (int l = 0; l < DEPTH; ++l) {
        const float* modl = c.MODS() + (size_t)l * 5 * (NMOD * DM);
#pragma unroll 1
        for (int sub = 0; sub < 3; ++sub) {
            REFRESH();
            phase_norm(c, l, sub, ((l == 0 && sub == 0) || (l == DEPTH - 1 && sub == 2)) ? 0 : (sub == 2 ? 4 : 11));
            GSYNC();
            if (sub != 1) {
                const int f = sub >> 1;
                pg8::Gemm g{c.A(), c.WGU() + (size_t)(l * 2 + f) * 5632 * 1024, MROWS, 5632, 1024, 16}; pg8::StaticOrder S; S.init(MROWS, 5632, c.G, c.bid);
                EpiSwiGLU E{c.H()};
                pg8::gemm_phase<EpiSwiGLU, pg8::StaticOrder, true, true>(c.lds, g, S, E, c.tid);
            } else {
                { pg8::Gemm g{c.A(), c.WIN() + (size_t)l * INW * 1024, MROWS, INW, 1024, 16}; pg8::StaticOrder S; S.init(MROWS, INW, c.G, c.bid);
                  EpiP E{c.P()};
                  pg8::gemm_phase<EpiP, pg8::StaticOrder, true, true>(c.lds, g, S, E, c.tid); }
                if (l + 1 < DEPTH) {
                    REFRESH();
                    LAS float* scr = (LAS float*)(c.lds + c.wave * 8704);
                    if (c.G == 256) { if (c.bid >= 84) for (int it = (c.bid - 84) * 8 + c.wave; it < TR_PER_LAYER; it += 172 * 8) transpose_layer_item(c, l + 1, it, scr); }
                    else for (int it = c.wave * c.G + c.bid; it < TR_PER_LAYER; it += c.G * 8) transpose_layer_item(c, l + 1, it, scr);
                }
                GSYNC();
                phase_p1(c, l);
                GSYNC();
                phase_p2(c, l);
                GSYNC();
                phase_p3(c, l);
            }
            GSYNC();
            {
                const bool ffn = sub != 1; const int f = sub >> 1;
                const int K = ffn ? DFF : 1024;
                const bf16_t* Ap = ffn ? c.H() : c.A(); const bf16_t* Bp = ffn ? c.WD() + (size_t)(l * 2 + f) * 1024 * DFF : c.WOUT() + (size_t)l * 1024 * 1024;
                pg8::Gemm g{Ap, Bp, MROWS, 1024, K, K / 64}; ResidOrder S; S.init(K, c.G, c.bid, l == DEPTH - 1 && sub >= 1);
                EpiResidBoth E{c.X(), c.PART(), modl, (3 * sub + 2) * DM, ffn ? 0.5f : 1.0f, (l == 0 && sub == 0) ? c.in(I_X) : nullptr};
                pg8::gemm_phase<EpiResidBoth, ResidOrder, true, true>(c.lds, g, S, E, c.tid);
            }
            GSYNC();
        }
    }
    phase_final(c);
}

extern "C" void kernel_launch(void* const* d_in, const int* in_sizes, int n_in, void* d_out, int out_size, void* d_ws, size_t ws_size, hipStream_t stream) {
    static int grid_blocks = 0;
    if (grid_blocks == 0) {
        if (n_in != 29 || ws_size < WS_END) { fprintf(stderr, "kernel_launch: unexpected n_in %d or ws_size %zu (< %zu)\n", n_in, ws_size, (size_t)WS_END); grid_blocks = -1; return; }
        int dev = 0, cus = 0, per_cu = 0;
        hipGetDevice(&dev);
        hipDeviceGetAttribute(&cus, hipDeviceAttributeMultiprocessorCount, dev);
        hipFuncSetAttribute((const void*)fwd_megakernel, hipFuncAttributeMaxDynamicSharedMemorySize, LDS_BYTES);
        hipOccupancyMaxActiveBlocksPerMultiprocessor(&per_cu, (const void*)fwd_megakernel, 512, LDS_BYTES);
        if (per_cu < 1) per_cu = 1;
        grid_blocks = cus * per_cu;
        fprintf(stderr, "kernel_launch: grid %d (cus %d x %d)\n", grid_blocks, cus, per_cu);
    }
    if (grid_blocks < 0) return;
    (void)hipMemsetAsync((unsigned char*)d_ws + WS_BAR, 0, 16384, stream);
    Params p{};
    for (int i = 0; i < 29; ++i) p.in[i] = (const float*)d_in[i];
    p.out = (float*)d_out; p.ws = (unsigned char*)d_ws;
    void* args[] = {&p};
    hipError_t e = hipLaunchCooperativeKernel((const void*)fwd_megakernel, dim3(grid_blocks), dim3(512), args, LDS_BYTES, stream);
    if (e != hipSuccess) fprintf(stderr, "cooperative launch failed: %s (grid %d)\n", hipGetErrorString(e), grid_blocks);
}
```
